# Optimizing an MI355X kernel written in HIP

```python
import math
import jax
import jax.numpy as jnp
from jax import lax
import numpy as np

D_MODEL = 1024
BATCH = 8
SEQ = 4096
DEPTH = 2

CTX_LEN = 256
GRID_W = 64
NORM_EPS = 1e-6

HY_CH = 256
HY_ORDER = 2
HY_DIRS = 2
HY_POS_EMB = 33
HY_FILT_HID = 64
HY_FILT_OUT = HY_ORDER * HY_DIRS * HY_CH
HY_FAST_DECAY = 0.3
HY_SLOW_DECAY = 1.5
HY_DECAY_TARGET = 1e-2

ML_HEADS = 4
ML_HD = 64
ML_W = ML_HEADS * ML_HD
ML_CHUNK = 64

DA_HEADS = 4
DA_HD = 64
DA_QK = DA_HEADS * 2 * DA_HD
DA_V = DA_HEADS * 2 * DA_HD
ROPE_THETA = 10000.0
Q_BLOCK = 128

HY_OFF = 0
ML_OFF = HY_OFF + 3 * HY_CH
DA_OFF = ML_OFF + 4 * ML_W + 2 * 2 * ML_HEADS
N_IN = DA_OFF + 2 * DA_QK + DA_V
MIX_W = HY_CH + ML_W + DA_V

MOE_GROUPS = 4
MOE_PER_GROUP = 8
MOE_EXPERTS = MOE_GROUPS * MOE_PER_GROUP
MOE_TOPK = 2
MOE_FF = 512
MOE_BLOCK = 128

kernel_name = 'hybrid_hyena_mlstm_diffattn_hmoe_dit'


def rmsnorm(x, w):
    xf = x.astype(jnp.float32)
    y = xf * lax.rsqrt(jnp.mean(xf * xf, axis=-1, keepdims=True) + NORM_EPS)
    return (y * w.astype(jnp.float32)).astype(x.dtype)


def short_conv(u, w, b):
    L = u.shape[1]
    up = jnp.pad(u, ((0, 0), (1, 1), (0, 0)))
    return up[:, :L] * w[0] + up[:, 1:L + 1] * w[1] + up[:, 2:] * w[2] + b


def hyena_filters(L, p):
    f32 = jnp.float32
    t = jnp.linspace(0.0, 1.0, L, dtype=f32)[:, None]
    bands = (HY_POS_EMB - 1) // 2
    w = (2.0 * math.pi / L) * jnp.arange(L, dtype=f32)[:, None]
    f = jnp.linspace(1e-4, bands - 1, bands, dtype=f32)[None, :]
    z = jnp.concatenate([t, jnp.cos(f * w), -jnp.sin(f * w)], axis=-1)
    freq = p['hy_sin_freq']
    h = jnp.sin(freq * (z @ p['hy_filt_w1'] + p['hy_filt_b1']))
    h = jnp.sin(freq * (h @ p['hy_filt_w2'] + p['hy_filt_b2']))
    h = (h @ p['hy_filt_w3'] + p['hy_filt_b3']).astype(f32).reshape(L, HY_ORDER, HY_DIRS, HY_CH)
    deltas = jnp.abs(jnp.linspace(math.log(HY_DECAY_TARGET) / HY_SLOW_DECAY,
                                  math.log(HY_DECAY_TARGET) / HY_FAST_DECAY, HY_CH, dtype=f32))
    h = h * jnp.exp(-t[:, :, None, None] * deltas)
    k_fwd, k_bwd = h[:, :, 0], h[:, :, 1]
    k = jnp.concatenate([k_fwd, jnp.zeros_like(k_fwd[:1]), k_bwd[:0:-1]], axis=0)
    return k / jnp.sum(jnp.abs(k), axis=0, keepdims=True)


def fft_long_conv(u, k, d):
    L = u.shape[1]
    y = jnp.fft.irfft(jnp.fft.rfft(u, n=2 * L, axis=1) * jnp.fft.rfft(k, axis=0)[None], n=2 * L, axis=1)[:, :L]
    return y + u * d


def hyena_mix(u, p):
    L = u.shape[1]
    u = short_conv(u, p['hy_conv_w'], p['hy_conv_b']).astype(jnp.float32)
    v, x1, x2 = jnp.split(u, 3, axis=-1)
    k = hyena_filters(L, p)
    z = v
    for o, gate in enumerate((x1, x2)):
        z = gate * fft_long_conv(z, k[:, o], p['hy_bias_d'][o].astype(jnp.float32))
    return z


def to_chunks(a):
    B, L, H = a.shape[:3]
    a = a.reshape((B, L // ML_CHUNK, ML_CHUNK, H) + a.shape[3:])
    return jnp.moveaxis(a, 3, 1)


def from_chunks(a):
    a = jnp.moveaxis(a, 1, 3)
    return a.reshape((a.shape[0], a.shape[1] * a.shape[2]) + a.shape[3:])


def mlstm_states(k, v, ig, lf, state0):
    b = jnp.cumsum(lf, axis=-1)
    a = b[..., -1:] - b + ig
    m_loc = jnp.max(a, axis=-1)
    wv = jnp.exp(a - m_loc[..., None])[..., None] * v
    C_loc = jnp.einsum('bhnli,bhnlj->bhnij', wv, k)
    n_loc = jnp.einsum('bhnl,bhnlj->bhnj', jnp.exp(a - m_loc[..., None]), k)

    def step(carry, xs):
        C, n, m = carry
        bL, Cl, nl, ml = xs
        m_new = jnp.maximum(bL + m, ml)
        s_old = jnp.exp(bL + m - m_new)
        s_loc = jnp.exp(ml - m_new)
        new = (s_old[..., None, None] * C + s_loc[..., None, None] * Cl,
               s_old[..., None] * n + s_loc[..., None] * nl, m_new)
        return new, carry

    xs = tuple(jnp.moveaxis(t, 2, 0) for t in (b[..., -1], C_loc, n_loc, m_loc))
    final, entering = lax.scan(step, state0, xs)
    entering = tuple(jnp.moveaxis(t, 0, 2) for t in entering)
    return b, entering, final


def mlstm_out(q, k, v, ig, b, entering):
    C0, n0, m0 = entering
    Lc = q.shape[3]
    lower = jnp.tril(jnp.ones((Lc, Lc), bool))
    D = jnp.where(lower, b[..., :, None] - b[..., None, :] + ig[..., None, :], -jnp.inf)
    inter = b + m0[..., None]
    m = jnp.maximum(inter, jnp.max(D, axis=-1))
    P = jnp.exp(D - m[..., None]) * jnp.einsum('bhnti,bhnsi->bhnts', q, k)
    w_inter = jnp.exp(inter - m)
    num = jnp.einsum('bhnts,bhnsj->bhntj', P, v) + w_inter[..., None] * jnp.einsum('bhnij,bhntj->bhnti', C0, q)
    den = jnp.sum(P, axis=-1) + w_inter * jnp.einsum('bhnj,bhntj->bhnt', n0, q)
    return num / jnp.maximum(jnp.abs(den), jnp.exp(-m))[..., None]


def mlstm_direction(q, k, v, ig, fg, state0, reverse, need_out):
    if reverse:
        q, k, v, ig, fg = (a[:, ::-1] for a in (q, k, v, ig, fg))
    lf = to_chunks(jax.nn.log_sigmoid(fg))
    q, k, v, ig = (to_chunks(a) for a in (q, k, v, ig))
    b, entering, final = mlstm_states(k, v, ig, lf, state0)
    if not need_out:
        return None, final
    h = from_chunks(mlstm_out(q, k, v, ig, b, entering))
    return (h[:, ::-1] if reverse else h), final


def mlstm_prep(u, p):
    B, L, _ = u.shape
    f32 = jnp.float32
    qk = jax.nn.silu(short_conv(u[..., :2 * ML_W], p['ml_conv_w'], p['ml_conv_b'])).astype(f32)
    q = qk[..., :ML_W].reshape(B, L, ML_HEADS, ML_HD)
    k = qk[..., ML_W:].reshape(B, L, ML_HEADS, ML_HD) * (ML_HD ** -0.5)
    v = u[..., 2 * ML_W:3 * ML_W].astype(f32).reshape(B, L, ML_HEADS, ML_HD)
    o = u[..., 3 * ML_W:4 * ML_W]
    g = u[..., 4 * ML_W:].astype(f32).reshape(B, L, 2, 2, ML_HEADS)
    return q, k, v, o, g


def mlstm_finish(h, o, w):
    B, L = h.shape[:2]
    hn = rmsnorm(h, w.reshape(ML_HEADS, ML_HD)).reshape(B, L, ML_W)
    return jax.nn.sigmoid(o.astype(jnp.float32)) * hn


def mlstm_mix(u_lat, u_ctx, p, ctx_out):
    ql, kl, vl, ol, gl = mlstm_prep(u_lat, p)
    qc, kc, vc, oc, gc = mlstm_prep(u_ctx, p)
    B = u_lat.shape[0]
    f32 = jnp.float32
    state0 = (jnp.zeros((B, ML_HEADS, ML_HD, ML_HD), f32), jnp.zeros((B, ML_HEADS, ML_HD), f32),
              jnp.zeros((B, ML_HEADS), f32))
    h_lat, h_ctx = [], []
    for d in range(2):
        hc_d, ctx_final = mlstm_direction(qc, kc, vc, gc[..., d, 0, :], gc[..., d, 1, :], state0, d == 1, ctx_out)
        hl_d, _ = mlstm_direction(ql, kl, vl, gl[..., d, 0, :], gl[..., d, 1, :], ctx_final, d == 1, True)
        h_lat.append(hl_d)
        h_ctx.append(hc_d)
    y_lat = mlstm_finish(h_lat[0] + h_lat[1], ol, p['ml_norm_w'])
    y_ctx = mlstm_finish(h_ctx[0] + h_ctx[1], oc, p['ml_norm_w']) if ctx_out else None
    return y_lat, y_ctx


def rope_tables(row, col):
    half = DA_HD // 2
    inv = ROPE_THETA ** (-jnp.arange(0, half, 2, dtype=jnp.float32) / half)
    ang = jnp.stack([row, col], axis=-1)[:, :, None] * inv
    ang = jnp.stack([ang, ang], axis=-2).reshape(-1, DA_HD)
    return jnp.cos(ang), jnp.sin(ang)


def axial_rope(x, cos, sin):
    xs = x.reshape(x.shape[:-1] + (2, 2, DA_HD // 4))
    rot = jnp.stack([-xs[..., 1, :], xs[..., 0, :]], axis=-2).reshape(x.shape)
    cos = cos[None, :, None, None, :]
    sin = sin[None, :, None, None, :]
    return (x * cos + rot * sin).astype(x.dtype)


def diff_core(q, k, v, lam):
    s = jnp.einsum('bqhmd,bkhmd->bhmqk', q, k, preferred_element_type=jnp.float32) * (DA_HD ** -0.5)
    pr = jax.nn.softmax(s, axis=-1)
    a = pr[:, :, 0] - lam * pr[:, :, 1]
    return jnp.einsum('bhqk,bkhe->bqhe', a.astype(v.dtype), v)


def diff_attention(u_lat, u_ctx, p, layer_idx, cos, sin, ctx_out):
    lam_init = 0.8 - 0.6 * math.exp(-0.3 * layer_idx)
    lp = p['da_lambda'].astype(jnp.float32)
    lam = jnp.exp(jnp.sum(lp[0] * lp[1])) - jnp.exp(jnp.sum(lp[2] * lp[3])) + lam_init

    def split(u):
        B, L, _ = u.shape
        q = u[..., :DA_QK].reshape(B, L, DA_HEADS, 2, DA_HD)
        k = u[..., DA_QK:2 * DA_QK].reshape(B, L, DA_HEADS, 2, DA_HD)
        v = u[..., 2 * DA_QK:].reshape(B, L, DA_HEADS, 2 * DA_HD)
        return q, k, v

    ql, kl, vl = split(u_lat)
    qc, kc, vc = split(u_ctx)
    ql = axial_rope(ql, cos, sin)
    kl = axial_rope(kl, cos, sin)
    k_all = jnp.concatenate([kl, kc], axis=1)
    v_all = jnp.concatenate([vl, vc], axis=1)
    B, L = ql.shape[:2]
    nb = L // Q_BLOCK
    qb = jnp.moveaxis(ql.reshape((B, nb, Q_BLOCK) + ql.shape[2:]), 1, 0)
    ob = lax.map(lambda qi: diff_core(qi, k_all, v_all, lam), qb)
    o_lat = jnp.moveaxis(ob, 0, 1).reshape(B, L, DA_HEADS, 2 * DA_HD)

    def finish(o):
        return (rmsnorm(o, p['da_subln_w']) * (1.0 - lam_init)).reshape(o.shape[0], o.shape[1], DA_V)

    y_lat = finish(o_lat)
    y_ctx = finish(diff_core(qc, kc, vc, lam)) if ctx_out else None
    return y_lat, y_ctx


def hier_moe(h, p):
    N, D = h.shape
    f32 = jnp.float32
    g_logits = (h @ p['moe_wg'] + p['moe_bg']).astype(f32)
    g_idx = jnp.argmax(g_logits, axis=-1)
    g_w = jnp.take_along_axis(jax.nn.softmax(g_logits, axis=-1), g_idx[:, None], axis=-1)
    e_logits = (h @ p['moe_we'] + p['moe_be']).astype(f32).reshape(N, MOE_GROUPS, MOE_PER_GROUP)
    e_logits = jnp.take_along_axis(e_logits, g_idx[:, None, None], axis=1)[:, 0]
    top_v, top_i = lax.top_k(e_logits, MOE_TOPK)
    gate = jax.nn.softmax(top_v, axis=-1) * g_w
    expert = g_idx[:, None] * MOE_PER_GROUP + top_i
    A = N * MOE_TOPK
    flat_e = expert.reshape(-1).astype(jnp.int32)
    flat_t = jnp.repeat(jnp.arange(N, dtype=jnp.int32), MOE_TOPK)
    flat_g = gate.reshape(-1)
    order = jnp.argsort(flat_e)
    se, st, sg = flat_e[order], flat_t[order], flat_g[order]
    counts = jnp.bincount(flat_e, length=MOE_EXPERTS)
    starts = jnp.cumsum(counts) - counts
    pcounts = (counts + MOE_BLOCK - 1) // MOE_BLOCK * MOE_BLOCK
    pends = jnp.cumsum(pcounts)
    dest = (pends - pcounts)[se] + jnp.arange(A, dtype=jnp.int32) - starts[se]
    P = -(-A // MOE_BLOCK) * MOE_BLOCK + MOE_EXPERTS * MOE_BLOCK
    nblk = P // MOE_BLOCK
    slot_tok = jnp.full((P,), N, jnp.int32).at[dest].set(st)
    slot_g = jnp.zeros((P,), f32).at[dest].set(sg)
    blk_e = jnp.minimum(jnp.searchsorted(pends, jnp.arange(nblk) * MOE_BLOCK, side='right'), MOE_EXPERTS - 1)
    xb = jnp.concatenate([h, jnp.zeros((1, D), h.dtype)], axis=0)[slot_tok].reshape(nblk, MOE_BLOCK, D)

    def expert_block(args):
        xi, e = args
        return (jax.nn.silu(xi @ p['moe_w1'][e]) * (xi @ p['moe_w3'][e])) @ p['moe_w2'][e]

    yb = lax.map(expert_block, (xb, blk_e)).reshape(P, D)
    out = jax.ops.segment_sum(yb.astype(f32) * slot_g[:, None], slot_tok, num_segments=N + 1)
    return out[:N].astype(h.dtype)


def trunk_layer(x, xc, c_act, cc_act, p, cos, sin, layer_idx, last):
    B, L, D = x.shape
    mod = (c_act @ p['ada_w'] + p['ada_b'])[:, None, :]
    modc = cc_act @ p['ada_w'] + p['ada_b']
    sh1, sc1, g1, sh2, sc2, g2 = jnp.split(mod, 6, axis=-1)
    csh1, csc1, cg1, csh2, csc2, cg2 = jnp.split(modc, 6, axis=-1)

    h = rmsnorm(x, p['norm1_w']) * (1.0 + sc1) + sh1
    hc = rmsnorm(xc, p['norm1_w']) * (1.0 + csc1) + csh1
    u = h @ p['w_in'] + p['b_in']
    c0 = ML_OFF if last else 0
    uc = hc @ p['w_in'][:, c0:] + p['b_in'][c0:]

    y_hy = hyena_mix(u[..., HY_OFF:ML_OFF], p).astype(x.dtype)
    y_ml, yc_ml = mlstm_mix(u[..., ML_OFF:DA_OFF], uc[..., ML_OFF - c0:DA_OFF - c0], p, not last)
    y_da, yc_da = diff_attention(u[..., DA_OFF:], uc[..., DA_OFF - c0:], p, layer_idx, cos, sin, not last)
    y = jnp.concatenate([y_hy, y_ml.astype(x.dtype), y_da.astype(x.dtype)], axis=-1) @ p['w_out']
    x = x + g1 * y
    if not last:
        yc_hy = hyena_mix(uc[..., HY_OFF:ML_OFF], p).astype(xc.dtype)
        yc = jnp.concatenate([yc_hy, yc_ml.astype(xc.dtype), yc_da.astype(xc.dtype)], axis=-1) @ p['w_out']
        xc = xc + cg1 * yc

    h2 = rmsnorm(x, p['norm2_w']) * (1.0 + sc2) + sh2
    if last:
        f = hier_moe(h2.reshape(B * L, D), p)
        return x + g2 * f.reshape(B, L, D), xc
    hc2 = rmsnorm(xc, p['norm2_w']) * (1.0 + csc2) + csh2
    f = hier_moe(jnp.concatenate([h2.reshape(B * L, D), hc2.reshape(-1, D)], axis=0), p)
    x = x + g2 * f[:B * L].reshape(B, L, D)
    xc = xc + cg2 * f[B * L:].reshape(xc.shape)
    return x, xc


def setup_inputs(seed: int = 0) -> dict:
    key = jax.random.key(seed)
    keys = jax.random.split(key, 34)
    f32 = jnp.float32

    def nrm(i, shape, scale):
        return scale * jax.random.normal(keys[i], shape, f32)

    D = D_MODEL
    fg_idx = np.array([ML_OFF + 4 * ML_W + d * 2 * ML_HEADS + ML_HEADS + hh for d in range(2) for hh in range(ML_HEADS)])
    fg_bias = jnp.asarray(np.tile(np.linspace(3.0, 6.0, ML_HEADS, dtype=np.float32), 2))
    return {
        'x': nrm(0, (BATCH, SEQ, D), 1.0),
        'c': nrm(1, (BATCH, D), 1.0),
        'ctx': nrm(2, (BATCH, CTX_LEN, D), 1.0),
        'c_ctx': nrm(3, (D,), 1.0),
        'ada_w': nrm(4, (DEPTH, D, 6 * D), 0.5 * D ** -0.5),
        'ada_b': nrm(5, (DEPTH, 6 * D), 0.02),
        'norm1_w': 1.0 + nrm(6, (DEPTH, D), 0.02),
        'norm2_w': 1.0 + nrm(7, (DEPTH, D), 0.02),
        'w_in': nrm(8, (DEPTH, D, N_IN), D ** -0.5),
        'b_in': nrm(9, (DEPTH, N_IN), 0.02).at[:, fg_idx].add(fg_bias),
        'w_out': nrm(10, (DEPTH, MIX_W, D), MIX_W ** -0.5),
        'hy_conv_w': nrm(11, (DEPTH, 3, 3 * HY_CH), 3 ** -0.5),
        'hy_conv_b': nrm(12, (DEPTH, 3 * HY_CH), 0.02),
        'hy_filt_w1': nrm(13, (DEPTH, HY_POS_EMB, HY_FILT_HID), HY_POS_EMB ** -0.5),
        'hy_filt_b1': nrm(14, (DEPTH, HY_FILT_HID), 0.02),
        'hy_filt_w2': nrm(15, (DEPTH, HY_FILT_HID, HY_FILT_HID), HY_FILT_HID ** -0.5),
        'hy_filt_b2': nrm(16, (DEPTH, HY_FILT_HID), 0.02),
        'hy_filt_w3': nrm(17, (DEPTH, HY_FILT_HID, HY_FILT_OUT), HY_FILT_HID ** -0.5),
        'hy_filt_b3': nrm(18, (DEPTH, HY_FILT_OUT), 0.02),
        'hy_sin_freq': 1.0 + nrm(19, (DEPTH, HY_FILT_HID), 0.02),
        'hy_bias_d': nrm(20, (DEPTH, HY_ORDER, HY_CH), 1.0),
        'ml_conv_w': nrm(21, (DEPTH, 3, 2 * ML_W), 3 ** -0.5),
        'ml_conv_b': nrm(22, (DEPTH, 2 * ML_W), 0.02),
        'ml_norm_w': 1.0 + nrm(23, (DEPTH, ML_W), 0.02),
        'da_lambda': nrm(24, (DEPTH, 4, DA_HD), 0.1),
        'da_subln_w': 1.0 + nrm(25, (DEPTH, 2 * DA_HD), 0.02),
        'moe_wg': nrm(26, (DEPTH, D, MOE_GROUPS), D ** -0.5),
        'moe_bg': nrm(27, (DEPTH, MOE_GROUPS), 0.01),
        'moe_we': nrm(28, (DEPTH, D, MOE_EXPERTS), D ** -0.5),
        'moe_be': nrm(29, (DEPTH, MOE_EXPERTS), 0.01),
        'moe_w1': nrm(30, (DEPTH, MOE_EXPERTS, D, MOE_FF), D ** -0.5),
        'moe_w3': nrm(31, (DEPTH, MOE_EXPERTS, D, MOE_FF), D ** -0.5),
        'moe_w2': nrm(32, (DEPTH, MOE_EXPERTS, MOE_FF, D), MOE_FF ** -0.5),
        'final_norm_w': 1.0 + nrm(33, (D,), 0.02),
    }


def reference(x, c, ctx, c_ctx, ada_w, ada_b, norm1_w, norm2_w, w_in, b_in, w_out,
              hy_conv_w, hy_conv_b, hy_filt_w1, hy_filt_b1, hy_filt_w2, hy_filt_b2, hy_filt_w3, hy_filt_b3,
              hy_sin_freq, hy_bias_d, ml_conv_w, ml_conv_b, ml_norm_w, da_lambda, da_subln_w,
              moe_wg, moe_bg, moe_we, moe_be, moe_w1, moe_w3, moe_w2, final_norm_w):
    B, L, D = x.shape
    ROWS = L // GRID_W
    row = jnp.repeat(jnp.arange(ROWS, dtype=jnp.float32), GRID_W)
    col = jnp.tile(jnp.arange(GRID_W, dtype=jnp.float32), ROWS)
    cos, sin = rope_tables(row, col)
    c_act = jax.nn.silu(c)
    cc_act = jax.nn.silu(c_ctx)
    xc = ctx
    for l in range(DEPTH):
        p = {
            'ada_w': ada_w[l], 'ada_b': ada_b[l], 'norm1_w': norm1_w[l], 'norm2_w': norm2_w[l],
            'w_in': w_in[l], 'b_in': b_in[l], 'w_out': w_out[l],
            'hy_conv_w': hy_conv_w[l], 'hy_conv_b': hy_conv_b[l],
            'hy_filt_w1': hy_filt_w1[l], 'hy_filt_b1': hy_filt_b1[l],
            'hy_filt_w2': hy_filt_w2[l], 'hy_filt_b2': hy_filt_b2[l],
            'hy_filt_w3': hy_filt_w3[l], 'hy_filt_b3': hy_filt_b3[l],
            'hy_sin_freq': hy_sin_freq[l], 'hy_bias_d': hy_bias_d[l],
            'ml_conv_w': ml_conv_w[l], 'ml_conv_b': ml_conv_b[l], 'ml_norm_w': ml_norm_w[l],
            'da_lambda': da_lambda[l], 'da_subln_w': da_subln_w[l],
            'moe_wg': moe_wg[l], 'moe_bg': moe_bg[l], 'moe_we': moe_we[l], 'moe_be': moe_be[l],
            'moe_w1': moe_w1[l], 'moe_w3': moe_w3[l], 'moe_w2': moe_w2[l],
        }
        x, xc = trunk_layer(x, xc, c_act, cc_act, p, cos, sin, l, l == DEPTH - 1)
    return rmsnorm(x, final_norm_w)
```

```cpp
#include <hip/hip_runtime.h>
#include <cstdio>
#include <cstdint>
#ifndef FAST_ATTN
#define FAST_ATTN 1
#endif
#ifndef FAST_HYENA
#define FAST_HYENA 1
#endif
#ifndef FAST_MLSTM
#define FAST_MLSTM 1
#endif
#ifndef DYN_MIX
#define DYN_MIX 1
#endif
#ifndef DUPMASK
#define DUPMASK 0
#endif
#define DUP(x) (1 + (((DUPMASK) >> (x)) & 1))

constexpr int DM = 1024, NB = 8, SEQ = 4096, CTXL = 256;
constexpr int NLAT = NB * SEQ;
constexpr int NCTX = NB * CTXL;
constexpr int MTOT = NLAT + NCTX;
constexpr int NIN = 3344;
constexpr int UW = 3328;
constexpr int NPADW = 3584;
constexpr int U_HY = 0, U_MLQ = 768, U_MLK = 1024, U_MLV = 1280, U_MLO = 1536, U_DAQ = 1792, U_DAK = 2304, U_DAV = 2816;
constexpr int NEXP = 32, FF = 512;
constexpr float EPS = 1e-6f;
constexpr float QSCALE = 0.125f * 1.4426950408889634f;

typedef unsigned short bf16;
typedef float f32x4 __attribute__((ext_vector_type(4)));
typedef unsigned u32x4 __attribute__((ext_vector_type(4)));
typedef unsigned u32x2 __attribute__((ext_vector_type(2)));

constexpr size_t MiB = 1u << 20;
constexpr size_t WS_CTL = 0, CTL_BYTES = 1 * MiB;
constexpr size_t WS_MODS = 1 * MiB;
constexpr size_t WS_ROPE = 2 * MiB;
constexpr size_t WS_H2L = 3 * MiB;
constexpr size_t WS_H2C = 5 * MiB;
constexpr size_t WS_LAM = 5 * MiB + 65536;
constexpr size_t WS_BINR = 5 * MiB + 131072;
constexpr size_t WS_WIN = 6 * MiB;
constexpr size_t WS_WOUT = 21 * MiB;
constexpr size_t WS_UPT = 25 * MiB;
constexpr size_t WS_DNT = 89 * MiB;
constexpr size_t WS_XC = 121 * MiB;
constexpr size_t WS_GATES = 129 * MiB;
constexpr size_t WS_EXPID = 132 * MiB;
constexpr size_t WS_GATEV = 132 * MiB + 512 * 1024;
constexpr size_t WS_LIST = 133 * MiB;
constexpr size_t WS_HB = 138 * MiB;
constexpr size_t WS_HYV = 206 * MiB, WS_HYX1 = 222 * MiB, WS_HYX2 = 238 * MiB, WS_HYY = 254 * MiB;
constexpr size_t WS_HYVC = 270 * MiB, WS_HYX1C = 271 * MiB, WS_HYX2C = 272 * MiB, WS_HYYC = 273 * MiB;
constexpr size_t WS_MLQ = 274 * MiB, WS_MLK = 291 * MiB;
constexpr size_t WS_MLH = 308 * MiB;
constexpr size_t WS_U = 342 * MiB;
constexpr size_t WS_HBUF = WS_U;
constexpr size_t WS_F = WS_U + 76 * MiB;
constexpr size_t WS_CST = WS_MLH;
constexpr size_t WS_NST = 563 * MiB;
constexpr size_t WS_MLOC = 563 * MiB + 1280 * 1024;
constexpr size_t WS_MENT = 563 * MiB + 1536 * 1024;
constexpr size_t WS_TAPS = 566 * MiB;
constexpr size_t WS_END = 582 * MiB;
constexpr int HBUF_ROWS = 77824;

constexpr int CW_BAR = 4096;
constexpr int CW_CNT = 40960;
constexpr int CNT_STRIDE = 64;
constexpr int CW_Q = 9216;

constexpr int NTHREADS = 512, NWAVES = 8;
constexpr int LDS_BYTES = 163840;
constexpr int LDS_CTL_OFF = 160 * 1024 - 256;

struct Params { const float* in[34]; float* out; unsigned char* ws; int ph_lo, ph_hi; };

enum { I_X = 0, I_C, I_CTX, I_CCTX, I_ADAW, I_ADAB, I_N1W, I_N2W, I_WIN, I_BIN, I_WOUT, I_HCW, I_HCB, I_FW1, I_FB1, I_FW2, I_FB2, I_FW3, I_FB3, I_FREQ, I_HBD,
       I_MCW, I_MCB, I_MNW, I_LAMBDA, I_SUBLN, I_WG, I_BG, I_WE, I_BE, I_W1, I_W3, I_W2, I_FNW };

__device__ __forceinline__ float bf2f(bf16 v) { return __uint_as_float(((unsigned)v) << 16); }
__device__ __forceinline__ bf16 f2bf(float f) { unsigned u = __float_as_uint(f); return (bf16)((u + 0x7fffu + ((u >> 16) & 1u)) >> 16); }
typedef float f32x2_t __attribute__((ext_vector_type(2))); typedef __bf16 bf16x2_t __attribute__((ext_vector_type(2)));
__device__ __forceinline__ unsigned cvtpk(float lo, float hi) { f32x2_t v = {lo, hi}; bf16x2_t b = __builtin_convertvector(v, bf16x2_t); return __builtin_bit_cast(unsigned, b); }
__device__ __forceinline__ unsigned pk2(float lo, float hi) { return cvtpk(lo, hi); }
__device__ __forceinline__ float wave_sum(float v) {
#pragma unroll
    for (int o = 1; o < 64; o <<= 1) v += __shfl_xor(v, o);
    return v;
}
__device__ __forceinline__ float siluf(float x) { return x * __builtin_amdgcn_rcpf(1.f + __expf(-x)); }
__device__ __forceinline__ float sigmoidf(float x) { return __builtin_amdgcn_rcpf(1.f + __expf(-x)); }
__device__ __forceinline__ float logsigmoidf(float x) { return fminf(x, 0.f) - log1pf(__expf(-fabsf(x))); }

#define LAS __attribute__((address_space(3)))
#define XB_TMO      128
#define XB_XCNT(j)  (256  + 64 * (j))
#define XB_XSUB(j)  (1280 + 64 * (j))
#define XB_XGEN(j)  (2304 + 64 * (j))
#define XB_TOP      3328
#define XB_TOPGEN   3392
#define XCD_BAR_WORDS 3456
#define XB_SPIN_CAP (1u << 24)
__device__ __forceinline__ unsigned xb_ld(unsigned* p)              { return __hip_atomic_load(p, __ATOMIC_RELAXED, __HIP_MEMORY_SCOPE_AGENT); }
__device__ __forceinline__ unsigned xb_add(unsigned* p, unsigned v) { return __hip_atomic_fetch_add(p, v, __ATOMIC_RELAXED, __HIP_MEMORY_SCOPE_AGENT); }
__device__ __forceinline__ unsigned xb_xcc_id() { return (unsigned)__builtin_amdgcn_s_getreg((3 << 11) | 20) & 0xFu; }
#define XB_SPIN(cond, bar) do { unsigned _sp = 0; while (cond) { __builtin_amdgcn_s_sleep(1); \
    if ((++_sp & 255u) == 0u) { if (xb_ld(&(bar)[XB_TMO])) break; if (_sp > XB_SPIN_CAP) { atomicAdd(&(bar)[XB_TMO], 1u); break; } } } } while (0)
struct XcdBarrier { unsigned* bar; unsigned x; volatile LAS unsigned* st; };
__device__ __forceinline__ XcdBarrier xcd_barrier_post(unsigned* bar, volatile LAS unsigned* st) {
    XcdBarrier b; b.bar = bar; b.x = xb_xcc_id(); b.st = st;
    if (threadIdx.x == 0) (void)xb_add(&bar[XB_XCNT(b.x)], 1u);
    return b;
}
__device__ __forceinline__ void xcd_barrier_complete(unsigned* bar, unsigned x, unsigned& nloc, unsigned& nx) {
    const unsigned G = gridDim.x * gridDim.y * gridDim.z;
    unsigned sum, cnt, mine, sp = 0u;
    for (;;) {
        sum = 0u; cnt = 0u; mine = 0u;
#pragma unroll
        for (unsigned j = 0; j < 16; ++j) { const unsigned c = xb_ld(&bar[XB_XCNT(j)]); sum += c; cnt += (c > 0u) ? 1u : 0u; mine = (j == x) ? c : mine; }
        if (sum == G) break;
        __builtin_amdgcn_s_sleep(1);
        if ((++sp & 255u) == 0u) { if (xb_ld(&bar[XB_TMO])) break; if (sp > XB_SPIN_CAP) { atomicAdd(&bar[XB_TMO], 1u); break; } }
    }
    nloc = mine > 0u ? mine : 1u; nx = cnt > 0u ? cnt : 1u;
}
__device__ __forceinline__ void xcd_barrier(const XcdBarrier& b) {
    asm volatile("s_waitcnt vmcnt(0)" ::: "memory");
    __syncthreads();
    if (threadIdx.x == 0) {
        unsigned* bar = b.bar;
        __builtin_amdgcn_s_waitcnt(0);
        unsigned nloc = b.st[0], nx = b.st[1];
        if (nloc == 0u) { xcd_barrier_complete(bar, b.x, nloc, nx); b.st[0] = nloc; b.st[1] = nx; }
        const unsigned old = xb_add(&bar[XB_XSUB(b.x)], 1u);
        const unsigned gen = old / nloc;
        if (old + 1u == (gen + 1u) * nloc) {
            __builtin_amdgcn_fence(__ATOMIC_RELEASE, "agent");
            asm volatile("s_waitcnt vmcnt(0)" ::: "memory");
            const unsigned og = xb_add(&bar[XB_TOP], 1u);
            const unsigned tg = og / nx;
            if (og + 1u == (tg + 1u) * nx) xb_add(&bar[XB_TOPGEN], 1u);
            else XB_SPIN(xb_ld(&bar[XB_TOPGEN]) == tg, bar);
            __builtin_amdgcn_fence(__ATOMIC_ACQUIRE, "agent");
            xb_add(&bar[XB_XGEN(b.x)], 1u);
            asm volatile("s_waitcnt vmcnt(0)" ::: "memory");
        } else {
            XB_SPIN(xb_ld(&bar[XB_XGEN(b.x)]) == gen, bar);
            __builtin_amdgcn_fence(__ATOMIC_ACQUIRE, "agent");
            asm volatile("s_waitcnt vmcnt(0)" ::: "memory");
        }
    }
    __syncthreads();
}

#define CAS __attribute__((address_space(4)))
struct Frame {
    unsigned char* lds; const CAS Params* p; unsigned char* ws;
    int tid, lane, wave, G, bid;
};
#define WSP(T, off) ((T*)(F.ws + (off)))
__device__ __forceinline__ Frame mkframe_(unsigned char* lds, int g_wave) {
    Frame F; F.lds = lds;
    unsigned long long pv = (unsigned long long)__builtin_amdgcn_kernarg_segment_ptr(); asm volatile("" : "+s"(pv));
    F.p = (const CAS Params*)pv; F.ws = F.p->ws;
    int tid = threadIdx.x; asm volatile("" : "+v"(tid)); F.tid = tid; F.lane = tid & 63; F.wave = __builtin_amdgcn_readfirstlane(tid >> 6);
    int g = gridDim.x, b = blockIdx.x; asm volatile("" : "+s"(g), "+s"(b)); F.G = g; F.bid = b;
    return F;
}

__device__ __forceinline__ void tr_item(const float* W, int ldw, int k0, int cs, int nvalid, bf16* WT, int ldt, int rd, float* scr, int lane, bool rperm = false) {
    { const int kr = lane >> 3, c4 = (lane & 7) * 4;
      f32x4 v[8];
#pragma unroll
      for (int i = 0; i < 8; ++i) v[i] = *(const f32x4*)(W + (size_t)(k0 + 8 * i + kr) * ldw + cs + c4);
#pragma unroll
      for (int i = 0; i < 8; ++i) { float* d = scr + (8 * i + kr) * 33;
#pragma unroll
          for (int q = 0; q < 4; ++q) { const int sc_ = c4 + q; const int n = rperm ? ((sc_ < 16) ? 2 * sc_ : 2 * (sc_ - 16) + 1) : sc_;
              d[n] = (sc_ < nvalid) ? v[i][q] : 0.f; } } }
    asm volatile("s_waitcnt lgkmcnt(0)" ::: "memory");
    const int c = lane & 7;
#pragma unroll
    for (int j = 0; j < 4; ++j) { const int n = (lane >> 3) + 8 * j; const float* s = scr + (8 * c) * 33 + n;
        u32x4 o; o.x = pk2(s[0 * 33], s[1 * 33]); o.y = pk2(s[2 * 33], s[3 * 33]); o.z = pk2(s[4 * 33], s[5 * 33]); o.w = pk2(s[6 * 33], s[7 * 33]);
        *(u32x4*)(WT + (size_t)(rd + n) * ldt + k0 + 8 * c) = o; }
    asm volatile("s_waitcnt lgkmcnt(0)" ::: "memory");
}
__device__ __forceinline__ void conv_moe_weights(Frame& F, int l) {
    float* scr = (float*)(F.lds) + F.wave * (64 * 33);
    const int gw = F.bid * NWAVES + F.wave, NGW = F.G * NWAVES;
    const float* w1 = F.p->in[I_W1] + (size_t)l * NEXP * DM * FF;
    const float* w3 = F.p->in[I_W3] + (size_t)l * NEXP * DM * FF;
    const float* w2 = F.p->in[I_W2] + (size_t)l * NEXP * FF * DM;
    bf16* UPT = WSP(bf16, WS_UPT); bf16* DNT = WSP(bf16, WS_DNT);
    for (int it = gw; it < 3 * 8192; it += NGW) {
        const int which = it / 8192, r = it % 8192, e = r / 256, q = r % 256;
        if (which < 2) { const int kb = q / 16, nb = q % 16, n0 = nb * 32, rd = (n0 >> 7) * 256 + (n0 & 127) + which * 128;
            tr_item((which ? w3 : w1) + (size_t)e * DM * FF, FF, kb * 64, n0, 32, UPT + (size_t)e * 1024 * 1024, 1024, rd, scr, F.lane); }
        else { const int kb = q / 32, nb = q % 32;
            tr_item(w2 + (size_t)e * FF * DM, DM, kb * 64, nb * 32, 32, DNT + (size_t)e * 1024 * 512, 512, nb * 32, scr, F.lane); }
    }
}
__device__ __forceinline__ void ph_prologue(Frame& F) {
    const CAS Params& P = *F.p;
    float* mods = WSP(float, WS_MODS);
    if (F.bid < 192) {
        float* act = (float*)F.lds;
        float* red = act + 9 * 1024;
        for (int i = F.tid; i < 9 * 1024; i += NTHREADS) act[i] = siluf(i < 8192 ? P.in[I_C][i] : P.in[I_CCTX][i - 8192]);
        __syncthreads();
        for (int it = F.bid; it < 192; it += F.G) {
            const int l = it / 96, nb = it % 96, n = nb * 64 + F.lane;
            const float* W = P.in[I_ADAW] + (size_t)l * DM * 6144;
            float acc[9];
#pragma unroll
            for (int r = 0; r < 9; ++r) acc[r] = 0.f;
#pragma unroll 16
            for (int k = F.wave * 128; k < F.wave * 128 + 128; ++k) {
                const float w = W[(size_t)k * 6144 + n];
#pragma unroll
                for (int r = 0; r < 9; ++r) acc[r] += act[r * 1024 + k] * w;
            }
#pragma unroll
            for (int r = 0; r < 9; ++r) red[(F.wave * 9 + r) * 64 + F.lane] = acc[r];
            __syncthreads();
            for (int o = F.tid; o < 576; o += NTHREADS) { const int r = o / 64, cl = o % 64; float s2 = 0.f;
                for (int w = 0; w < 8; ++w) s2 += red[(w * 9 + r) * 64 + cl];
                mods[(size_t)(l * 9 + r) * 6144 + nb * 64 + cl] = s2 + P.in[I_ADAB][l * 6144 + nb * 64 + cl]; }
            __syncthreads();
        }
    }
    __syncthreads();
}
__device__ __forceinline__ void ph_prologue_b(Frame& F) {
    const CAS Params& P = *F.p;
    const int gw = F.bid * NWAVES + F.wave, NGW = F.G * NWAVES;
    const int gt = F.bid * NTHREADS + F.tid, NGT = F.G * NTHREADS;
    {
        float* scr = (float*)(F.lds) + F.wave * (64 * 33);
        bf16* WIN = WSP(bf16, WS_WIN); bf16* WOUT = WSP(bf16, WS_WOUT);
        for (int base_ = 0; base_ < 2 * 16 * 105 + 2 * 16 * 32; base_ += NGW) { const int it = (base_ + NGW > 2 * 16 * 105 + 2 * 16 * 32) ? base_ + (NGW - 1 - gw) : base_ + gw; if (it >= 2 * 16 * 105 + 2 * 16 * 32) break;
            if (it < 3360) { const int l = it / 1680, r = it % 1680, kb = r / 105, nbk = r % 105;
                int cs, rd, nv = 32;
                if (nbk < 56) { cs = 32 * nbk; rd = 32 * nbk; } else if (nbk < 104) { cs = 1808 + 32 * (nbk - 56); rd = 32 * nbk; } else { cs = 1792; rd = 3328; nv = 16; }
                tr_item(P.in[I_WIN] + (size_t)l * DM * NIN, NIN, kb * 64, cs, nv, WIN + (size_t)l * NPADW * DM, DM, rd, scr, F.lane, nbk >= 56 && nbk < 88);
            } else { const int r0 = it - 3360, l = r0 / 512, r = r0 % 512, kb = r / 32, nb = r % 32;
                tr_item(P.in[I_WOUT] + (size_t)l * DM * DM, DM, kb * 64, nb * 32, 32, WOUT + (size_t)l * DM * DM, DM, nb * 32, scr, F.lane); }
        }
        for (int i = gt; i < 2 * 224 * (DM / 8); i += NGT) { const int l = i / (224 * 128), r = i % (224 * 128);
            *(u32x4*)(WIN + (size_t)l * NPADW * DM + (size_t)(3360 + r / 128) * DM + (r % 128) * 8) = (u32x4){0u, 0u, 0u, 0u}; }
    }
    if (!DYN_MIX) conv_moe_weights(F, 0);
    { float* rc = WSP(float, WS_ROPE); float* rs = rc + 4096 * 32;
      for (int i = gt; i < 4096 * 32; i += NGT) { const int t = i >> 5, k = i & 31; const float pos = (k < 16) ? (float)(t >> 6) : (float)(t & 63);
          const float inv = powf(10000.f, -(float)(2 * (k & 15)) / 32.f); const float ang = pos * inv; rc[i] = cosf(ang); rs[i] = sinf(ang); } }
    { float* H2L = WSP(float, WS_H2L); float* H2C = WSP(float, WS_H2C);
      for (int base_ = 0; base_ < 2 * 4096 + 256; base_ += NGW) { const int it = (base_ + NGW > 2 * 4096 + 256) ? base_ + (NGW - 1 - gw) : base_ + gw; if (it >= 2 * 4096 + 256) break;
          int l, t, L; float* dst;
          if (it < 8192) { l = it >> 12; t = it & 4095; L = 4096; dst = H2L + ((size_t)l * 4096 + t) * 64; } else { l = 0; t = it - 8192; L = 256; dst = H2C + (size_t)t * 64; }
          const float tn = (float)t / (float)(L - 1);
          const float w = (6.283185307179586f / (float)L) * (float)t;
          const int j = F.lane;
          float zk = 0.f;
          if (j == 0) zk = tn;
          else if (j <= 16) { const float f = 1e-4f + (float)(j - 1) * ((15.f - 1e-4f) / 15.f); zk = cosf(f * w); }
          else if (j <= 32) { const float f = 1e-4f + (float)(j - 17) * ((15.f - 1e-4f) / 15.f); zk = -sinf(f * w); }
          const float* w1 = P.in[I_FW1] + (size_t)l * 33 * 64; const float* w2 = P.in[I_FW2] + (size_t)l * 64 * 64;
          const float fr = P.in[I_FREQ][l * 64 + j];
          float a = P.in[I_FB1][l * 64 + j];
#pragma unroll
          for (int k = 0; k < 33; ++k) a += __shfl(zk, k) * w1[k * 64 + j];
          const float h1 = sinf(fr * a);
          float b = P.in[I_FB2][l * 64 + j];
#pragma unroll
          for (int k = 0; k < 64; ++k) b += __shfl(h1, k) * w2[k * 64 + j];
          dst[j] = sinf(fr * b);
      } }
    if (F.bid == 0 && F.wave == 0) {
        for (int l = 0; l < 2; ++l) { const float* lp = P.in[I_LAMBDA] + l * 256;
            const float s1 = wave_sum(lp[F.lane] * lp[64 + F.lane]), s2 = wave_sum(lp[128 + F.lane] * lp[192 + F.lane]);
            if (F.lane == 0) WSP(float, WS_LAM)[l] = expf(s1) - expf(s2) + (0.8f - 0.6f * expf(-0.3f * (float)l)); }
    }
    { float* BR = WSP(float, WS_BINR);
      for (int i = gt; i < 2 * NPADW; i += NGT) { const int l = i / NPADW, n = i % NPADW; float v = 0.f;
          if (n < 1792) v = P.in[I_BIN][l * NIN + n]; else if (n < 2816) { const int q = n & 31; v = P.in[I_BIN][l * NIN + (n & ~31) + 16 + (q >> 1) + 16 * (q & 1)]; } else if (n < 3328) v = P.in[I_BIN][l * NIN + n + 16]; else if (n < 3344) v = P.in[I_BIN][l * NIN + 1792 + (n - 3328)];
          BR[i] = v; } }
}

__device__ __forceinline__ bf16* xrow_ptr(float* out, unsigned char* ws, int row) { return row < NLAT ? (bf16*)out + (size_t)row * 2048 + 1024 : (bf16*)(ws + WS_XC) + (size_t)(row - NLAT) * DM; }
template <bool FIN>
__device__ __forceinline__ void ph_norm1(Frame& F, int l) {
    const CAS Params& P = *F.p;
    const int gw = F.bid * NWAVES + F.wave, NGW = F.G * NWAVES;
    const float* mods = WSP(float, WS_MODS);
    bf16* HB = WSP(bf16, WS_HB); const bf16* FB = WSP(bf16, WS_F);
    const int nrows = FIN ? NLAT : MTOT;
    f32x4 nv[4]; u32x2 nx[4], na[4], nb[4];
#define N1_LOAD(R) do { const int r_ = (R); \
        if (l == 0) { const float* src_ = r_ < NLAT ? P.in[I_X] + (size_t)r_ * DM : P.in[I_CTX] + (size_t)(r_ - NLAT) * DM; \
            _Pragma("unroll") for (int j = 0; j < 4; ++j) nv[j] = *(const f32x4*)(src_ + 256 * j + 4 * F.lane); } \
        else { const bf16* xb_ = xrow_ptr(P.out, F.ws, r_); \
            _Pragma("unroll") for (int j = 0; j < 4; ++j) { const int c_ = 256 * j + 4 * F.lane; nx[j] = *(const u32x2*)(xb_ + c_); na[j] = *(const u32x2*)(FB + (size_t)r_ * DM + c_); nb[j] = *(const u32x2*)(FB + (size_t)(MTOT + r_) * DM + c_); } } } while (0)
    if (gw < nrows) N1_LOAD(gw);
    f32x4 wv[4];
    { const float* wsrc = FIN ? P.in[I_FNW] : P.in[I_N1W] + l * DM;
#pragma unroll
      for (int j = 0; j < 4; ++j) wv[j] = *(const f32x4*)(wsrc + 256 * j + 4 * F.lane); }
    for (int row = gw; row < nrows; row += NGW) {
        const int bsel = row < NLAT ? (row >> 12) : 8;
        bf16* Xb = xrow_ptr(P.out, F.ws, row);
        f32x4 v[4]; u32x2 cx[4], ca[4], cb2[4];
#pragma unroll
        for (int j = 0; j < 4; ++j) { v[j] = nv[j]; cx[j] = nx[j]; ca[j] = na[j]; cb2[j] = nb[j]; }
        if (row + NGW < nrows) N1_LOAD(row + NGW);
        f32x4 s1v[4], s0v[4];
        if (!FIN) { const float* sh_ = mods + (size_t)(l * 9 + bsel) * 6144; const float* sc_ = sh_ + DM;
#pragma unroll
            for (int j = 0; j < 4; ++j) { s1v[j] = *(const f32x4*)(sc_ + 256 * j + 4 * F.lane); s0v[j] = *(const f32x4*)(sh_ + 256 * j + 4 * F.lane); } }
        if (l != 0) { const float* g2 = mods + (size_t)((l - 1) * 9 + bsel) * 6144 + 5 * DM;
#pragma unroll
            for (int j = 0; j < 4; ++j) { const int c = 256 * j + 4 * F.lane; const u32x2 xv = cx[j]; const f32x4 g = *(const f32x4*)(g2 + c);
                const u32x2 a = ca[j], b = cb2[j];
                v[j].x = __uint_as_float(xv.x << 16) + g.x * (__uint_as_float(a.x << 16) + __uint_as_float(b.x << 16)); v[j].y = __uint_as_float(xv.x & 0xffff0000u) + g.y * (__uint_as_float(a.x & 0xffff0000u) + __uint_as_float(b.x & 0xffff0000u));
                v[j].z = __uint_as_float(xv.y << 16) + g.z * (__uint_as_float(a.y << 16) + __uint_as_float(b.y << 16)); v[j].w = __uint_as_float(xv.y & 0xffff0000u) + g.w * (__uint_as_float(a.y & 0xffff0000u) + __uint_as_float(b.y & 0xffff0000u)); } }
        float ss = 0.f;
#pragma unroll
        for (int j = 0; j < 4; ++j) ss += (v[j].x * v[j].x + v[j].y * v[j].y) + (v[j].z * v[j].z + v[j].w * v[j].w);
        const float rstd = rsqrtf(wave_sum(ss) * (1.f / DM) + EPS);
        if (FIN) {
            float* Orow = P.out + (size_t)row * DM;
#pragma unroll
            for (int j = 0; j < 4; ++j) { const int c = 256 * j + 4 * F.lane; const f32x4 w = wv[j];
                *(f32x4*)(Orow + c) = v[j] * rstd * w; }
        } else {
#pragma unroll
            for (int j = 0; j < 4; ++j) { const int c = 256 * j + 4 * F.lane; u32x2 xo; xo.x = pk2(v[j].x, v[j].y); xo.y = pk2(v[j].z, v[j].w); *(u32x2*)(Xb + c) = xo;
                const f32x4 w = wv[j], s1 = s1v[j], s0 = s0v[j];
                const f32x4 h = v[j] * rstd * w * (s1 + 1.f) + s0;
                u32x2 o; o.x = pk2(h.x, h.y); o.y = pk2(h.z, h.w); *(u32x2*)(HB + (size_t)row * DM + c) = o; }
        }
    }
}

#undef N1_LOAD
template <int NBM, class AR, class EP>
__device__ __forceinline__ void ngemm_tile(Frame& F, const bf16* A, int lda, const bf16* const (&Bt)[NBM], int ldb, int K, AR arow, EP epi) {
    float* As = (float*)F.lds;
    float* Bs = As + 32 * 132;
    const int ty = F.tid >> 4, tx = F.tid & 15;
    float acc[NBM][4][4];
#pragma unroll
    for (int q = 0; q < NBM; ++q)
#pragma unroll
        for (int i = 0; i < 4; ++i)
#pragma unroll
            for (int j = 0; j < 4; ++j) acc[q][i][j] = 0.f;
    const int lr = F.tid >> 2, lk = (F.tid & 3) * 8;
    const long ar = arow(lr);
    for (int k0 = 0; k0 < K; k0 += 32) {
        { u32x4 v = (u32x4){0u, 0u, 0u, 0u}; if (ar >= 0) v = *(const u32x4*)(A + (size_t)ar * lda + k0 + lk);
          As[(lk + 0) * 132 + lr] = __uint_as_float(v.x << 16); As[(lk + 1) * 132 + lr] = __uint_as_float(v.x & 0xffff0000u);
          As[(lk + 2) * 132 + lr] = __uint_as_float(v.y << 16); As[(lk + 3) * 132 + lr] = __uint_as_float(v.y & 0xffff0000u);
          As[(lk + 4) * 132 + lr] = __uint_as_float(v.z << 16); As[(lk + 5) * 132 + lr] = __uint_as_float(v.z & 0xffff0000u);
          As[(lk + 6) * 132 + lr] = __uint_as_float(v.w << 16); As[(lk + 7) * 132 + lr] = __uint_as_float(v.w & 0xffff0000u); }
        if (F.tid < 256) {
#pragma unroll
            for (int q = 0; q < NBM; ++q) { const u32x4 v = *(const u32x4*)(Bt[q] + (size_t)lr * ldb + k0 + lk); float* bs = Bs + q * 32 * 68;
              bs[(lk + 0) * 68 + lr] = __uint_as_float(v.x << 16); bs[(lk + 1) * 68 + lr] = __uint_as_float(v.x & 0xffff0000u);
              bs[(lk + 2) * 68 + lr] = __uint_as_float(v.y << 16); bs[(lk + 3) * 68 + lr] = __uint_as_float(v.y & 0xffff0000u);
              bs[(lk + 4) * 68 + lr] = __uint_as_float(v.z << 16); bs[(lk + 5) * 68 + lr] = __uint_as_float(v.z & 0xffff0000u);
              bs[(lk + 6) * 68 + lr] = __uint_as_float(v.w << 16); bs[(lk + 7) * 68 + lr] = __uint_as_float(v.w & 0xffff0000u); }
        }
        __syncthreads();
#pragma unroll 4
        for (int kk = 0; kk < 32; ++kk) {
            const f32x4 a = *(const f32x4*)(As + kk * 132 + ty * 4);
#pragma unroll
            for (int q = 0; q < NBM; ++q) { const f32x4 b = *(const f32x4*)(Bs + q * 32 * 68 + kk * 68 + tx * 4);
#pragma unroll
                for (int i = 0; i < 4; ++i) { acc[q][i][0] += a[i] * b[0]; acc[q][i][1] += a[i] * b[1]; acc[q][i][2] += a[i] * b[2]; acc[q][i][3] += a[i] * b[3]; } }
        }
        __syncthreads();
    }
    epi(acc, ty * 4, tx * 4);
}

__device__ __forceinline__ void ph_win_naive(Frame& F, int l) {
    const bf16* HB = WSP(bf16, WS_HB); const bf16* W = WSP(bf16, WS_WIN) + (size_t)l * NPADW * DM; const float* bias = WSP(float, WS_BINR) + l * NPADW;
    bf16* U = WSP(bf16, WS_U); float* GT = WSP(float, WS_GATES);
    const int nmt = MTOT / 128, nnt = 53;
    for (int it = F.bid; it < nmt * nnt; it += F.G) {
        const int mt = it / nnt, nt = it % nnt, m0 = mt * 128, n0 = nt * 64;
        const bf16* const Bt[1] = { W + (size_t)n0 * DM };
        ngemm_tile<1>(F, HB, DM, Bt, DM, DM, [&](int i) { return (long)(m0 + i); },
            [&](float (&acc)[1][4][4], int r0, int c0) {
#pragma unroll
                for (int i = 0; i < 4; ++i)
#pragma unroll
                    for (int j = 0; j < 4; ++j) { const int row = m0 + r0 + i, col = n0 + c0 + j; const float v = acc[0][i][j] + bias[col];
                        if (col < UW) U[(size_t)row * UW + col] = f2bf(v); else if (col < UW + 16) GT[(size_t)row * 16 + col - UW] = v; }
            });
    }
}
__device__ __forceinline__ void ph_wout_naive(Frame& F, int l) {
    const CAS Params& P = *F.p;
    const bf16* MIX = WSP(bf16, WS_HB); const bf16* W = WSP(bf16, WS_WOUT) + (size_t)l * DM * DM; const float* mods = WSP(float, WS_MODS); float* XC = WSP(float, WS_XC);
    const int M = (l == 1) ? NLAT : MTOT; const int nmt = M / 128, nnt = 16;
    for (int it = F.bid; it < nmt * nnt; it += F.G) {
        const int mt = it / nnt, nt = it % nnt, m0 = mt * 128, n0 = nt * 64;
        const bf16* const Bt[1] = { W + (size_t)n0 * DM };
        ngemm_tile<1>(F, MIX, DM, Bt, DM, DM, [&](int i) { return (long)(m0 + i); },
            [&](float (&acc)[1][4][4], int r0, int c0) {
#pragma unroll
                for (int i = 0; i < 4; ++i) { const int row = m0 + r0 + i; const int bsel = row < NLAT ? (row >> 12) : 8;
                    float* Xrow = row < NLAT ? P.out + (size_t)row * DM : XC + (size_t)(row - NLAT) * DM; const float* g1 = mods + (size_t)(l * 9 + bsel) * 6144 + 2 * DM;
#pragma unroll
                    for (int j = 0; j < 4; ++j) { const int col = n0 + c0 + j; Xrow[col] += g1[col] * acc[0][i][j]; } }
            });
    }
}

#define PU_UNPK(v, f) do { f[0] = __uint_as_float(v.x << 16); f[1] = __uint_as_float(v.x & 0xffff0000u); f[2] = __uint_as_float(v.y << 16); f[3] = __uint_as_float(v.y & 0xffff0000u); \
        f[4] = __uint_as_float(v.z << 16); f[5] = __uint_as_float(v.z & 0xffff0000u); f[6] = __uint_as_float(v.w << 16); f[7] = __uint_as_float(v.w & 0xffff0000u); } while (0)
__device__ __forceinline__ void ph_postu(Frame& F, int l) {
    const CAS Params& P = *F.p;
    const bf16* U = WSP(bf16, WS_U);
    {
        const float* cw = P.in[I_HCW] + (size_t)l * 3 * 768; const float* cb = P.in[I_HCB] + (size_t)l * 768;
        const int gw = F.bid * NWAVES + F.wave, NGW = F.G * NWAVES;
        bf16* T = (bf16*)(F.lds + F.wave * 9216);
        const int nrowblk = (l == 0) ? MTOT / 64 : NLAT / 64;
        for (int it = gw; it < nrowblk * 12; it += NGW) {
            const int rb = it / 12, cbk = it % 12, row0 = rb * 64, c0 = cbk * 64;
            const bool lat = row0 < NLAT; const int t0 = lat ? (row0 & 4095) : ((row0 - NLAT) & 255); const int Ls = lat ? SEQ : CTXL; const int seq = lat ? (row0 >> 12) : ((row0 - NLAT) >> 8);
            asm volatile("s_waitcnt lgkmcnt(0)" ::: "memory");
#pragma unroll
            for (int q = 0; q < 9; ++q) { const int i = q * 64 + F.lane; if (i < 66 * 8) { const int rr = i >> 3, ch = i & 7; const int t = t0 - 1 + rr;
                u32x4 v = (u32x4){0u, 0u, 0u, 0u}; if (t >= 0 && t < Ls) v = *(const u32x4*)(U + (size_t)(row0 - 1 + rr) * UW + U_HY + c0 + ch * 8);
                *(u32x2*)(T + rr * 68 + ch * 8) = (u32x2){v.x, v.y}; *(u32x2*)(T + rr * 68 + ch * 8 + 4) = (u32x2){v.z, v.w}; } }
            asm volatile("s_waitcnt lgkmcnt(0)" ::: "memory");
            const int j = c0 + F.lane; const float w0 = cw[j], w1 = cw[768 + j], w2 = cw[1536 + j], bb = cb[j];
            const int which = j >> 8, chn = j & 255;
            bf16* dst = (lat ? WSP(bf16, which == 0 ? WS_HYV : which == 1 ? WS_HYX1 : WS_HYX2) : WSP(bf16, which == 0 ? WS_HYVC : which == 1 ? WS_HYX1C : WS_HYX2C)) + ((size_t)chn * 8 + seq) * Ls + t0;
            float xm = bf2f(T[F.lane]), x0 = bf2f(T[68 + F.lane]);
#pragma unroll
            for (int g = 0; g < 8; ++g) { float o[8];
#pragma unroll
                for (int q = 0; q < 8; ++q) { const float xp = bf2f(T[(g * 8 + q + 2) * 68 + F.lane]); o[q] = w0 * xm + w1 * x0 + w2 * xp + bb; xm = x0; x0 = xp; }
                u32x4 ov; ov.x = pk2(o[0], o[1]); ov.y = pk2(o[2], o[3]); ov.z = pk2(o[4], o[5]); ov.w = pk2(o[6], o[7]);
                *(u32x4*)(dst + g * 8) = ov; }
        }
    }
    __syncthreads();
    {
        const float* cw = P.in[I_MCW] + (size_t)l * 3 * 512; const float* cb = P.in[I_MCB] + (size_t)l * 512;
        bf16* MLQ = WSP(bf16, WS_MLQ); bf16* MLK = WSP(bf16, WS_MLK);
        const int gt = F.bid * NTHREADS + F.tid, NGT = F.G * NTHREADS;
        float cw0[8], cw1[8], cw2[8], cbb[8];
        { const int colh = (gt & 63) * 8;
#pragma unroll
          for (int h4 = 0; h4 < 2; ++h4) { const f32x4 a4 = *(const f32x4*)(cw + colh + 4 * h4), c4 = *(const f32x4*)(cw + 512 + colh + 4 * h4), d4 = *(const f32x4*)(cw + 1024 + colh + 4 * h4), b4 = *(const f32x4*)(cb + colh + 4 * h4);
              cw0[4 * h4] = a4.x; cw0[4 * h4 + 1] = a4.y; cw0[4 * h4 + 2] = a4.z; cw0[4 * h4 + 3] = a4.w; cw1[4 * h4] = c4.x; cw1[4 * h4 + 1] = c4.y; cw1[4 * h4 + 2] = c4.z; cw1[4 * h4 + 3] = c4.w;
              cw2[4 * h4] = d4.x; cw2[4 * h4 + 1] = d4.y; cw2[4 * h4 + 2] = d4.z; cw2[4 * h4 + 3] = d4.w; cbb[4 * h4] = b4.x; cbb[4 * h4 + 1] = b4.y; cbb[4 * h4 + 2] = b4.z; cbb[4 * h4 + 3] = b4.w; } }
        for (int idx0 = gt; idx0 < MTOT * 64; idx0 += 4 * NGT) {
            u32x4 v0[4], v1[4], v2[4];
#pragma unroll
            for (int q4 = 0; q4 < 4; ++q4) { const int idx = idx0 + q4 * NGT; v0[q4] = (u32x4){0u, 0u, 0u, 0u}; v1[q4] = v0[q4]; v2[q4] = v0[q4];
                if (idx < MTOT * 64) { const int row = idx >> 6, col = (idx & 63) * 8;
                    const int tin = row < NLAT ? (row & 4095) : ((row - NLAT) & 255); const int Ls = row < NLAT ? SEQ : CTXL;
                    const bf16* up = U + (size_t)row * UW + U_MLQ + col;
                    v1[q4] = *(const u32x4*)up; if (tin > 0) v0[q4] = *(const u32x4*)(up - UW); if (tin < Ls - 1) v2[q4] = *(const u32x4*)(up + UW); } }
#pragma unroll
            for (int q4 = 0; q4 < 4; ++q4) { const int idx = idx0 + q4 * NGT;
                if (idx < MTOT * 64) { const int row = idx >> 6, col = (idx & 63) * 8;
                    float a[8], c[8], d[8], o[8]; PU_UNPK(v0[q4], a); PU_UNPK(v1[q4], c); PU_UNPK(v2[q4], d);
                    const float sc = (col >= 256) ? 0.125f : 1.f;
#pragma unroll
                    for (int q = 0; q < 8; ++q) o[q] = siluf(cw0[q] * a[q] + cw1[q] * c[q] + cw2[q] * d[q] + cbb[q]) * sc;
                    u32x4 ov; ov.x = pk2(o[0], o[1]); ov.y = pk2(o[2], o[3]); ov.z = pk2(o[4], o[5]); ov.w = pk2(o[6], o[7]);
                    *(u32x4*)(((col >= 256) ? MLK : MLQ) + (size_t)row * 256 + (col & 255)) = ov; } }
        }
    }
}
#undef PU_UNPK

__device__ __forceinline__ void ph_taps(Frame& F, int l) {
    const CAS Params& P = *F.p;
    float* hs = (float*)F.lds;
    float* ws = hs + 64 * 65;
    const float* h2 = WSP(float, WS_H2L) + (size_t)l * 4096 * 64; const float* w3 = P.in[I_FW3] + (size_t)l * 64 * 1024; const float* b3 = P.in[I_FB3] + (size_t)l * 1024;
    float* TAPS = WSP(float, WS_TAPS);
    const float lo = logf(0.01f) / 1.5f, hi = logf(0.01f) / 0.3f;
    for (int it = F.bid; it < 64 * 16; it += F.G) {
        const int tb = it >> 4, cbk = it & 15, t0 = tb * 64, c0 = cbk * 64;
        for (int i = F.tid; i < 64 * 16; i += NTHREADS) { const int r = i >> 4, q = i & 15; const f32x4 v = *(const f32x4*)(h2 + (size_t)(t0 + r) * 64 + q * 4);
            hs[r * 65 + q * 4] = v.x; hs[r * 65 + q * 4 + 1] = v.y; hs[r * 65 + q * 4 + 2] = v.z; hs[r * 65 + q * 4 + 3] = v.w; }
        for (int i = F.tid; i < 64 * 16; i += NTHREADS) { const int k = i >> 4, q = i & 15; *(f32x4*)(ws + k * 64 + q * 4) = *(const f32x4*)(w3 + (size_t)k * 1024 + c0 + q * 4); }
        __syncthreads();
        { const int tq = F.tid & 63, cg = (F.tid >> 6) * 8; float acc[8];
#pragma unroll
          for (int q = 0; q < 8; ++q) acc[q] = b3[c0 + cg + q];
#pragma unroll 8
          for (int k = 0; k < 64; ++k) { const float h = hs[tq * 65 + k]; const f32x4 wa = *(const f32x4*)(ws + k * 64 + cg), wb = *(const f32x4*)(ws + k * 64 + cg + 4);
              acc[0] += h * wa.x; acc[1] += h * wa.y; acc[2] += h * wa.z; acc[3] += h * wa.w; acc[4] += h * wb.x; acc[5] += h * wb.y; acc[6] += h * wb.z; acc[7] += h * wb.w; }
          const float tn = (float)(t0 + tq) / 4095.f;
#pragma unroll
          for (int q = 0; q < 8; ++q) { const int col = c0 + cg + q; const float delta = fabsf(lo + (hi - lo) * ((float)(col & 255) / 255.f));
              TAPS[(size_t)col * 4096 + t0 + tq] = acc[q] * expf(-tn * delta); } }
        __syncthreads();
    }
}
__device__ __forceinline__ void hy_taps(Frame& F, int l, int o, int c, int L, const float* h2tab, float* T, float* red  , const float* pre = nullptr  ) {
    const CAS Params& P = *F.p;
    const float* w3 = P.in[I_FW3] + (size_t)l * 64 * 1024; const float* b3 = P.in[I_FB3] + (size_t)l * 1024;
    if (F.tid < 128) { const int dir = F.tid >> 6, k = F.tid & 63; red[F.tid] = w3[(size_t)k * 1024 + o * 512 + dir * 256 + c]; }
    if (F.tid < 2) red[128 + F.tid] = b3[o * 512 + F.tid * 256 + c];
    if (F.tid == 0) T[0] = 0.f;
    __syncthreads();
    const float lo = logf(0.01f) / 1.5f, hi = logf(0.01f) / 0.3f;
    const float delta = fabsf(lo + (hi - lo) * ((float)c / 255.f));
    float asum = 0.f;
    if (pre) {
        const float* p0 = pre + (size_t)(o * 512 + c) * L; const float* p1 = pre + (size_t)(o * 512 + 256 + c) * L;
        for (int t4 = F.tid * 4; t4 < L; t4 += NTHREADS * 4) { const f32x4 a = *(const f32x4*)(p0 + t4), bq = *(const f32x4*)(p1 + t4);
            T[L + t4] = a.x; T[L + t4 + 1] = a.y; T[L + t4 + 2] = a.z; T[L + t4 + 3] = a.w; asum += (fabsf(a.x) + fabsf(a.y)) + (fabsf(a.z) + fabsf(a.w));
            if (t4 >= 1) { T[L - t4] = bq.x; asum += fabsf(bq.x); } T[L - t4 - 1] = bq.y; T[L - t4 - 2] = bq.z; T[L - t4 - 3] = bq.w; asum += fabsf(bq.y) + fabsf(bq.z) + fabsf(bq.w); }
    } else
    for (int t = F.tid; t < L; t += NTHREADS) {
        const f32x4* hrow = (const f32x4*)(h2tab + (size_t)t * 64); float a0 = red[128], a1 = red[129];
#pragma unroll
        for (int k4 = 0; k4 < 16; ++k4) { const f32x4 h = hrow[k4]; const f32x4 w0 = *(const f32x4*)(red + 4 * k4), w1 = *(const f32x4*)(red + 64 + 4 * k4);
            a0 += (h.x * w0.x + h.y * w0.y) + (h.z * w0.z + h.w * w0.w); a1 += (h.x * w1.x + h.y * w1.y) + (h.z * w1.z + h.w * w1.w); }
        const float tn = (float)t / (float)(L - 1); const float dec = expf(-tn * delta);
        a0 *= dec; a1 *= dec;
        T[L + t] = a0; asum += fabsf(a0);
        if (t >= 1) { T[L - t] = a1; asum += fabsf(a1); }
    }
    asum = wave_sum(asum);
    __syncthreads();
    if (F.lane == 0) red[132 + F.wave] = asum;
    __syncthreads();
    float tot = 0.f;
#pragma unroll
    for (int w = 0; w < 8; ++w) tot += red[132 + w];
    const float inv = 1.f / tot;
    for (int idx = F.tid; idx < 2 * L; idx += NTHREADS) T[idx] *= inv;
    __syncthreads();
}
__device__ __forceinline__ void hy_naive_item(Frame& F, int l, int c, int b, int L, const float* h2tab, const bf16* V, const bf16* X1, const bf16* X2, bf16* Y) {
    const CAS Params& P = *F.p;
    float* T = (float*)F.lds;
    float* z = T + 2 * L;
    float* red = z + L;
    const size_t base = ((size_t)c * 8 + b) * L;
    for (int i = F.tid; i < L; i += NTHREADS) z[i] = bf2f(V[base + i]);
    const int per = L / NTHREADS > 0 ? L / NTHREADS : 1;
    for (int o = 0; o < 2; ++o) {
        hy_taps(F, l, o, c, L, h2tab, T, red);
        const float dd = P.in[I_HBD][(size_t)l * 512 + o * 256 + c];
        const bf16* G = (o == 0) ? X1 : X2;
        float res[8];
#pragma unroll
        for (int q = 0; q < 8; ++q) res[q] = 0.f;
        if (F.tid < L) {
            for (int s = 0; s < L; ++s) { const float zs = z[s];
#pragma unroll
                for (int q = 0; q < 8; ++q) if (q < per) { const int t = F.tid + q * NTHREADS; res[q] += T[t - s + L] * zs; } }
#pragma unroll
            for (int q = 0; q < 8; ++q) if (q < per) { const int t = F.tid + q * NTHREADS; res[q] = bf2f(G[base + t]) * (res[q] + dd * z[t]); }
        }
        __syncthreads();
        if (F.tid < L) {
#pragma unroll
            for (int q = 0; q < 8; ++q) if (q < per) { const int t = F.tid + q * NTHREADS; if (o == 0) z[t] = bf2f(f2bf(res[q])); else Y[base + t] = f2bf(res[q]); }
        }
        __syncthreads();
    }
}

namespace hy {
typedef short bf16x8 __attribute__((ext_vector_type(8)));
typedef float f32x16 __attribute__((ext_vector_type(16)));
constexpr int ZP = 5000, ZPAD = 448;
constexpr int Z_OFF = 0, RA_OFF = 80000, RB_OFF = 80000 + 16384 + 68, TF_OFF = 112896, RED_OFF = TF_OFF + 32768;
__device__ __forceinline__ int crow(int r, int hi) { return (r & 3) + 8 * (r >> 2) + 4 * hi; }
__device__ __forceinline__ void unit(Frame& F, int l, int c) {
    const Params CAS& P = *F.p;
    bf16* Z = (bf16*)(F.lds + Z_OFF); bf16* RA = (bf16*)(F.lds + RA_OFF); bf16* RB = (bf16*)(F.lds + RB_OFF); float* Tf = (float*)(F.lds + TF_OFF); float* red = (float*)(F.lds + RED_OFF);
    const bf16* V = WSP(bf16, WS_HYV) + (size_t)c * 8 * SEQ; const float* h2tab = WSP(float, WS_H2L) + (size_t)l * 4096 * 64;
    const int lane = F.lane, r32 = lane & 31, hi = lane >> 5, w = F.wave;
#pragma unroll
    for (int it8 = 0; it8 < 8; ++it8) { const int i = F.tid + it8 * NTHREADS; const int b = i >> 9, q = i & 511; *(u32x4*)(Z + b * ZP + ZPAD + q * 8) = *(const u32x4*)(V + (size_t)b * SEQ + q * 8); }
    for (int i = F.tid; i < 8 * 2 * (ZPAD / 8); i += NTHREADS) { const int b = i / (2 * (ZPAD / 8)), q = i % (2 * (ZPAD / 8)); const int off = (q < ZPAD / 8) ? q * 8 : ZPAD + SEQ + (q - ZPAD / 8) * 8;
        *(u32x4*)(Z + b * ZP + off) = (u32x4){0u, 0u, 0u, 0u}; }
    for (int o = 0; o < 2; ++o) {
        hy_taps(F, l, o, c, SEQ, h2tab, Tf, red, WSP(float, WS_TAPS));
        for (int k = F.tid; k < 8192; k += NTHREADS) { const float a = (k >= 1) ? Tf[8192 - k] : 0.f; const float bq = (k + 1 <= 8191) ? Tf[8192 - (k + 1)] : 0.f; RA[k] = f2bf(a); RB[k] = f2bf(bq); }
        __syncthreads();
        f32x16 acc[2][2];
#pragma unroll
        for (int cb = 0; cb < 2; ++cb)
#pragma unroll
            for (int rh = 0; rh < 2; ++rh) acc[cb][rh] = f32x16{};
        const unsigned* RAw = (const unsigned*)RA; const unsigned* RBw = (const unsigned*)RB;
        const int nb = r32 & 7, ntb = r32 >> 3;
        const bf16* zb = Z + nb * ZP + ZPAD + (8 * w + ntb) * 64 + 8 * hi;
        for (int dl = 8 * w - 63; dl <= 8 * w + 7; ++dl) {
            bf16x8 af[6];
#pragma unroll
            for (int q = 0; q < 6; ++q) { const int mm = 4 * dl + (q - 3); const int k0 = 4096 - 16 * mm + 8 * hi - r32; const int par = k0 & 1; const unsigned* src = (par ? RBw : RAw) + ((k0 - par) >> 1);
                u32x4 v; v.x = src[0]; v.y = src[1]; v.z = src[2]; v.w = src[3]; af[q] = __builtin_bit_cast(bf16x8, v); }
#pragma unroll
            for (int cb = 0; cb < 2; ++cb)
#pragma unroll
                for (int ks = 0; ks < 4; ++ks) { const bf16x8 bf = *(const bf16x8*)(zb + (4 * cb - dl) * 64 + 16 * ks);
#pragma unroll
                    for (int rh = 0; rh < 2; ++rh) acc[cb][rh] = __builtin_amdgcn_mfma_f32_32x32x16_bf16(af[2 * rh - ks + 3], bf, acc[cb][rh], 0, 0, 0); }
        }
        __syncthreads();
        const float dd = P.in[I_HBD][(size_t)l * 512 + o * 256 + c];
        const bf16* G = WSP(bf16, o == 0 ? WS_HYX1 : WS_HYX2) + ((size_t)c * 8 + nb) * SEQ; bf16* Y = WSP(bf16, WS_HYY) + ((size_t)c * 8 + nb) * SEQ;
        u32x2 gvv[2][2][4];
#pragma unroll
        for (int cb = 0; cb < 2; ++cb)
#pragma unroll
            for (int rh = 0; rh < 2; ++rh)
#pragma unroll
                for (int g = 0; g < 4; ++g) gvv[cb][rh][g] = *(const u32x2*)(G + (8 * w + 4 * cb + ntb) * 64 + 32 * rh + 8 * g + 4 * hi);
        __builtin_amdgcn_sched_barrier(0);
#pragma unroll
        for (int cb = 0; cb < 2; ++cb)
#pragma unroll
            for (int rh = 0; rh < 2; ++rh)
#pragma unroll
                for (int g = 0; g < 4; ++g) { const int t = (8 * w + 4 * cb + ntb) * 64 + 32 * rh + 8 * g + 4 * hi;
                    const u32x2 zi = *(const u32x2*)(Z + nb * ZP + ZPAD + t), gv = gvv[cb][rh][g];
                    const float r0 = __uint_as_float(gv.x << 16) * (acc[cb][rh][4 * g + 0] + dd * __uint_as_float(zi.x << 16)), r1 = __uint_as_float(gv.x & 0xffff0000u) * (acc[cb][rh][4 * g + 1] + dd * __uint_as_float(zi.x & 0xffff0000u));
                    const float r2 = __uint_as_float(gv.y << 16) * (acc[cb][rh][4 * g + 2] + dd * __uint_as_float(zi.y << 16)), r3 = __uint_as_float(gv.y & 0xffff0000u) * (acc[cb][rh][4 * g + 3] + dd * __uint_as_float(zi.y & 0xffff0000u));
                    u32x2 ov; ov.x = cvtpk(r0, r1); ov.y = cvtpk(r2, r3);
                    if (o == 0) *(u32x2*)(Z + nb * ZP + ZPAD + t) = ov; else *(u32x2*)(Y + t) = ov; }
        __syncthreads();
    }
}
}

__device__ __forceinline__ void ml_naive_item(Frame& F, int b, int hh, int dir) {
    const bf16* MLQ = WSP(bf16, WS_MLQ); const bf16* MLK = WSP(bf16, WS_MLK); const bf16* U = WSP(bf16, WS_U); const float* GT = WSP(float, WS_GATES);
    bf16* MLH = WSP(bf16, WS_MLH) + (size_t)dir * MTOT * 256;
    const int i = F.tid >> 3, jg = F.tid & 7;
    float C[8], n[8]; float m = 0.f;
#pragma unroll
    for (int q = 0; q < 8; ++q) { C[q] = 0.f; n[q] = 0.f; }
    for (int step = 0; step < CTXL + SEQ; ++step) {
        long row;
        if (step < CTXL) { const int t = dir ? (CTXL - 1 - step) : step; row = NLAT + (long)b * CTXL + t; }
        else { const int s2 = step - CTXL; const int t = dir ? (SEQ - 1 - s2) : s2; row = (long)b * SEQ + t; }
        const u32x4 kq = *(const u32x4*)(MLK + row * 256 + hh * 64 + jg * 8), qq = *(const u32x4*)(MLQ + row * 256 + hh * 64 + jg * 8);
        const float v = bf2f(U[row * UW + U_MLV + hh * 64 + i]);
        const float ig = GT[row * 16 + dir * 8 + hh], fg = GT[row * 16 + dir * 8 + 4 + hh];
        float kf[8], qf[8];
        kf[0] = __uint_as_float(kq.x << 16); kf[1] = __uint_as_float(kq.x & 0xffff0000u); kf[2] = __uint_as_float(kq.y << 16); kf[3] = __uint_as_float(kq.y & 0xffff0000u);
        kf[4] = __uint_as_float(kq.z << 16); kf[5] = __uint_as_float(kq.z & 0xffff0000u); kf[6] = __uint_as_float(kq.w << 16); kf[7] = __uint_as_float(kq.w & 0xffff0000u);
        qf[0] = __uint_as_float(qq.x << 16); qf[1] = __uint_as_float(qq.x & 0xffff0000u); qf[2] = __uint_as_float(qq.y << 16); qf[3] = __uint_as_float(qq.y & 0xffff0000u);
        qf[4] = __uint_as_float(qq.z << 16); qf[5] = __uint_as_float(qq.z & 0xffff0000u); qf[6] = __uint_as_float(qq.w << 16); qf[7] = __uint_as_float(qq.w & 0xffff0000u);
        const float lf = logsigmoidf(fg);
        const float mn = fmaxf(lf + m, ig);
        const float so = expf(lf + m - mn), sl = expf(ig - mn);
        float num = 0.f, den = 0.f;
#pragma unroll
        for (int q = 0; q < 8; ++q) { C[q] = so * C[q] + sl * v * kf[q]; n[q] = so * n[q] + sl * kf[q]; num += C[q] * qf[q]; den += n[q] * qf[q]; }
        m = mn;
        num += __shfl_xor(num, 1); num += __shfl_xor(num, 2); num += __shfl_xor(num, 4);
        den += __shfl_xor(den, 1); den += __shfl_xor(den, 2); den += __shfl_xor(den, 4);
        if (jg == 0) MLH[row * 256 + hh * 64 + i] = f2bf(num / fmaxf(fabsf(den), expf(-mn)));
    }
}

namespace ml {
typedef short bf16x8 __attribute__((ext_vector_type(8)));
typedef short s16x4 __attribute__((ext_vector_type(4)));
typedef short v4i16_t __attribute__((ext_vector_type(4)));
typedef float f32x16 __attribute__((ext_vector_type(16)));
typedef __attribute__((address_space(3))) const char* lds_cptr;
__device__ __forceinline__ int crow(int r, int hi) { return (r & 3) + 8 * (r >> 2) + 4 * hi; }
__device__ __forceinline__ long slot_row0(int b, int slot) { return slot < 4 ? (long)NLAT + (long)b * CTXL + slot * 64 : (long)b * SEQ + (long)(slot - 4) * 64; }
__device__ __forceinline__ float scan_add(float v, int lane) {
#pragma unroll
    for (int o = 1; o < 64; o <<= 1) { const float t = __shfl_up(v, o); if (lane >= o) v += t; }
    return v; }
__device__ __forceinline__ float scan_max_up(float v, int lane) {
#pragma unroll
    for (int o = 1; o < 64; o <<= 1) { const float t = __shfl_up(v, o); if (lane >= o) v = fmaxf(v, t); }
    return v; }
__device__ __forceinline__ float scan_max_dn(float v, int lane) {
#pragma unroll
    for (int o = 1; o < 64; o <<= 1) { const float t = __shfl_down(v, o); if (lane + o < 64) v = fmaxf(v, t); }
    return v; }
__device__ __forceinline__ float wave_max(float v) {
#pragma unroll
    for (int o = 1; o < 64; o <<= 1) v = fmaxf(v, __shfl_xor(v, o));
    return v; }
__device__ __forceinline__ float swapadd(float m) { auto rr = __builtin_amdgcn_permlane32_swap(__float_as_uint(m), __float_as_uint(m), false, false); return __uint_as_float(rr[0]) + __uint_as_float(rr[1]); }
__device__ __forceinline__ int img_off(int row, int col8) { return ((col8 >> 2) * 4 + (row >> 4)) * 1024 + (row & 15) * 64 + (col8 & 3) * 16; }
__device__ __forceinline__ bf16x8 tr_frag(lds_cptr img, int cb, int ks, int lane) {
    const int hi = lane >> 5;
    const lds_cptr p = img + (cb * 4 + ks) * 1024 + (4 * hi + ((lane & 15) >> 2)) * 64 + ((lane >> 4) & 1) * 32 + (lane & 3) * 8;
    const s16x4 lo = __builtin_bit_cast(s16x4, __builtin_amdgcn_ds_read_tr16_b64_v4i16((__attribute__((address_space(3))) v4i16_t*)p));
    const s16x4 hv = __builtin_bit_cast(s16x4, __builtin_amdgcn_ds_read_tr16_b64_v4i16((__attribute__((address_space(3))) v4i16_t*)(p + 512)));
    return (bf16x8){lo[0], lo[1], lo[2], lo[3], hv[0], hv[1], hv[2], hv[3]};
}
#define ML_UNPK(v, f) do { f[0] = __uint_as_float(v.x << 16); f[1] = __uint_as_float(v.x & 0xffff0000u); f[2] = __uint_as_float(v.y << 16); f[3] = __uint_as_float(v.y & 0xffff0000u); \
        f[4] = __uint_as_float(v.z << 16); f[5] = __uint_as_float(v.z & 0xffff0000u); f[6] = __uint_as_float(v.w << 16); f[7] = __uint_as_float(v.w & 0xffff0000u); } while (0)

__device__ __forceinline__ void s1_item(Frame& F, int l, int b, int hh, int slot, unsigned char* lw  , int dir_lo, int dir_hi) {
    const Params CAS& P = *F.p;
    const bf16* U = WSP(bf16, WS_U); const float* GT = WSP(float, WS_GATES);
    bf16* CST = WSP(bf16, WS_CST); float* NST = WSP(float, WS_NST); float* MLOC = WSP(float, WS_MLOC);
    const int lane = F.lane, r32 = lane & 31, hi = lane >> 5;
    const long row0 = slot_row0(b, slot), row = row0 + lane;
    const bool has_prev = !((slot == 0 || slot == 4) && lane == 0), has_next = !((slot == 3 || slot == 67) && lane == 63);
    unsigned char* Kimg = lw; unsigned char* Vimg = lw + 8192; float* es = (float*)(lw + 16384);
    const lds_cptr K3 = (lds_cptr)(__attribute__((address_space(3))) unsigned char*)Kimg; const lds_cptr V3 = (lds_cptr)(__attribute__((address_space(3))) unsigned char*)Vimg;
    float igv[2], fgv[2];
#pragma unroll
    for (int d_ = 0; d_ < 2; ++d_) { igv[d_] = GT[row * 16 + d_ * 8 + hh]; fgv[d_] = GT[row * 16 + d_ * 8 + 4 + hh]; }
    { const int rsub = lane >> 3, cq = lane & 7;
      const float* cw = P.in[I_MCW] + (size_t)l * 3 * 512 + 256 + hh * 64 + cq * 8; const float* cb = P.in[I_MCB] + (size_t)l * 512 + 256 + hh * 64 + cq * 8;
      float w0[8], w1[8], w2[8], bb[8];
#pragma unroll
      for (int h4 = 0; h4 < 2; ++h4) { const f32x4 a4 = *(const f32x4*)(cw + 4 * h4), c4 = *(const f32x4*)(cw + 512 + 4 * h4), d4 = *(const f32x4*)(cw + 1024 + 4 * h4), b4 = *(const f32x4*)(cb + 4 * h4);
          w0[4 * h4] = a4.x; w0[4 * h4 + 1] = a4.y; w0[4 * h4 + 2] = a4.z; w0[4 * h4 + 3] = a4.w; w1[4 * h4] = c4.x; w1[4 * h4 + 1] = c4.y; w1[4 * h4 + 2] = c4.z; w1[4 * h4 + 3] = c4.w;
          w2[4 * h4] = d4.x; w2[4 * h4 + 1] = d4.y; w2[4 * h4 + 2] = d4.z; w2[4 * h4 + 3] = d4.w; bb[4 * h4] = b4.x; bb[4 * h4 + 1] = b4.y; bb[4 * h4 + 2] = b4.z; bb[4 * h4 + 3] = b4.w; }
      const bf16* up = U + (size_t)(row0 + rsub) * UW + U_MLK + hh * 64 + cq * 8;
      u32x4 t0[8], t1[8], t2[8];
#pragma unroll
      for (int i = 0; i < 8; ++i) { const int rl = i * 8 + rsub;
          const bool hp = !((slot == 0 || slot == 4) && rl == 0), hn = !((slot == 3 || slot == 67) && rl == 63);
          const bf16* pc = up + (size_t)i * 8 * UW;
          t1[i] = *(const u32x4*)pc; t0[i] = *(const u32x4*)(hp ? pc - UW : pc); t2[i] = *(const u32x4*)(hn ? pc + UW : pc); }
#pragma unroll
      for (int i = 0; i < 8; ++i) { const int rl = i * 8 + rsub;
          const bool hp = !((slot == 0 || slot == 4) && rl == 0), hn = !((slot == 3 || slot == 67) && rl == 63);
          const u32x4 z4 = (u32x4){0u, 0u, 0u, 0u}; const u32x4 v0 = hp ? t0[i] : z4, v1 = t1[i], v2 = hn ? t2[i] : z4;
          float a[8], c[8], d[8], o[8]; ML_UNPK(v0, a); ML_UNPK(v1, c); ML_UNPK(v2, d);
#pragma unroll
          for (int q = 0; q < 8; ++q) o[q] = siluf(w0[q] * a[q] + w1[q] * c[q] + w2[q] * d[q] + bb[q]) * 0.125f;
          u32x4 w; w.x = pk2(o[0], o[1]); w.y = pk2(o[2], o[3]); w.z = pk2(o[4], o[5]); w.w = pk2(o[6], o[7]);
          *(u32x4*)(Kimg + img_off(rl, cq)) = w; } }
    u32x4 vraw[8];
    { const int rsub = lane >> 3, cq = lane & 7; const bf16* vp = U + (size_t)(row0 + rsub) * UW + U_MLV + hh * 64 + cq * 8;
#pragma unroll
      for (int i = 0; i < 8; ++i) vraw[i] = *(const u32x4*)(vp + (size_t)i * 8 * UW); }
#pragma unroll 1
    for (int dir = dir_lo; dir < dir_hi; ++dir) {
        const int seq = (b * 4 + hh) * 2 + dir;
        const float ig = (dir == 0) ? igv[0] : igv[1], fg = (dir == 0) ? fgv[0] : fgv[1];
        const float lf = logsigmoidf(fg); const float bc = scan_add(lf, lane); const float tot = __shfl(bc, 63);
        const float a = (dir == 0) ? (tot - bc + ig) : (bc - lf + ig);
        const float mloc = wave_max(a); const float e = __expf(a - mloc);
        asm volatile("s_waitcnt lgkmcnt(0)" ::: "memory");
        es[lane] = e;
        asm volatile("s_waitcnt lgkmcnt(0)" ::: "memory");
        { const int rsub = lane >> 3, cq = lane & 7;
#pragma unroll
          for (int i = 0; i < 8; ++i) { const u32x4 v = vraw[i]; const float er = es[i * 8 + rsub]; float f[8]; ML_UNPK(v, f);
              u32x4 w; w.x = pk2(f[0] * er, f[1] * er); w.y = pk2(f[2] * er, f[3] * er); w.z = pk2(f[4] * er, f[5] * er); w.w = pk2(f[6] * er, f[7] * er);
              *(u32x4*)(Vimg + img_off(i * 8 + rsub, cq)) = w; } }
        asm volatile("s_waitcnt lgkmcnt(0)" ::: "memory");
        f32x16 acc[2][2];
#pragma unroll
        for (int jb = 0; jb < 2; ++jb)
#pragma unroll
            for (int ib = 0; ib < 2; ++ib) acc[jb][ib] = f32x16{};
#pragma unroll
        for (int ls = 0; ls < 4; ++ls) { bf16x8 ka[2], vb[2];
#pragma unroll
            for (int q = 0; q < 2; ++q) { ka[q] = tr_frag(K3, q, ls, lane); vb[q] = tr_frag(V3, q, ls, lane); }
#pragma unroll
            for (int jb = 0; jb < 2; ++jb)
#pragma unroll
                for (int ib = 0; ib < 2; ++ib) acc[jb][ib] = __builtin_amdgcn_mfma_f32_32x32x16_bf16(ka[jb], vb[ib], acc[jb][ib], 0, 0, 0); }
        bf16* cdst = CST + ((size_t)seq * 68 + slot) * 4096;
#pragma unroll
        for (int jb = 0; jb < 2; ++jb)
#pragma unroll
            for (int ib = 0; ib < 2; ++ib)
#pragma unroll
                for (int g = 0; g < 4; ++g) { u32x2 ov; ov.x = cvtpk(acc[jb][ib][4 * g], acc[jb][ib][4 * g + 1]); ov.y = cvtpk(acc[jb][ib][4 * g + 2], acc[jb][ib][4 * g + 3]);
                    *(u32x2*)(cdst + (32 * ib + r32) * 64 + 32 * jb + 8 * g + 4 * hi) = ov; }
        { float nl = 0.f; const unsigned short* kc = (const unsigned short*)(Kimg + ((lane >> 5) * 4) * 1024 + ((lane & 31) >> 3) * 16 + (lane & 7) * 2);
#pragma unroll 8
          for (int ll = 0; ll < 64; ++ll) nl += es[ll] * bf2f(kc[(ll >> 4) * 512 + (ll & 15) * 32]);
          NST[((size_t)seq * 68 + slot) * 64 + lane] = nl; }
        if (lane == 0) { MLOC[((size_t)seq * 68 + slot) * 2] = mloc; MLOC[((size_t)seq * 68 + slot) * 2 + 1] = tot; }
    }
}
__device__ __forceinline__ void s2_item(Frame& F, int seq, int rg) {
    bf16* CST = WSP(bf16, WS_CST) + (size_t)seq * 68 * 4096; float* NST = WSP(float, WS_NST) + (size_t)seq * 68 * 64; const float* MLOC = WSP(float, WS_MLOC) + (size_t)seq * 68 * 2; float* MENT = WSP(float, WS_MENT) + (size_t)seq * 68;
    const int lane = F.lane, dir = seq & 1;
    const int eoff = (rg * 8 + (lane >> 3)) * 64 + (lane & 7) * 8;
    float C[8], n = 0.f, m = 0.f;
#pragma unroll
    for (int q = 0; q < 8; ++q) C[q] = 0.f;
#define ML_SLOT(st) ((dir == 0) ? (st) : (((st) < 4) ? 3 - (st) : 71 - (st)))
#pragma unroll 1
    for (int st0 = 0; st0 < 68; st0 += 17) {
        u32x4 xb[17]; float nlb[17]; float mlb[17], blb[17];
#pragma unroll
        for (int i = 0; i < 17; ++i) { const int slot = ML_SLOT(st0 + i);
            xb[i] = *(const u32x4*)(CST + (size_t)slot * 4096 + eoff); nlb[i] = (lane < 8) ? NST[slot * 64 + rg * 8 + lane] : 0.f; mlb[i] = MLOC[slot * 2]; blb[i] = MLOC[slot * 2 + 1]; }
#pragma unroll
        for (int i = 0; i < 17; ++i) { const int cs = ML_SLOT(st0 + i);
            u32x4 w; w.x = pk2(C[0], C[1]); w.y = pk2(C[2], C[3]); w.z = pk2(C[4], C[5]); w.w = pk2(C[6], C[7]);
            *(u32x4*)(CST + (size_t)cs * 4096 + eoff) = w;
            if (lane < 8) NST[cs * 64 + rg * 8 + lane] = n;
            if (rg == 0 && lane == 0) MENT[cs] = m;
            const float mn = fmaxf(blb[i] + m, mlb[i]); const float so = __expf(blb[i] + m - mn), sl = __expf(mlb[i] - mn);
            float f[8]; ML_UNPK(xb[i], f);
#pragma unroll
            for (int q = 0; q < 8; ++q) C[q] = so * C[q] + sl * f[q];
            n = so * n + sl * nlb[i]; m = mn; }
    }
#undef ML_SLOT
}
__device__ __forceinline__ void s3_item(Frame& F, int l, int b, int hh, int slot, unsigned char* lw  ) {
    const Params CAS& P = *F.p;
    const bf16* U = WSP(bf16, WS_U); const float* GT = WSP(float, WS_GATES); const bf16* MLQ = WSP(bf16, WS_MLQ); const bf16* MLK = WSP(bf16, WS_MLK);
    const bf16* CST = WSP(bf16, WS_CST); const float* NST = WSP(float, WS_NST); const float* MENT = WSP(float, WS_MENT); bf16* MIX = WSP(bf16, WS_HB);
    const int lane = F.lane, r32 = lane & 31, hi = lane >> 5;
    const long row0 = slot_row0(b, slot), row = row0 + lane;
    unsigned char* Vimg = lw; float* gs = (float*)(lw + 8192); float* n0s = gs + 128;
    const lds_cptr V3 = (lds_cptr)(__attribute__((address_space(3))) unsigned char*)Vimg;
    const size_t sidx0 = (size_t)((b * 4 + hh) * 2) * 68 + slot, sidx1 = sidx0 + 68;
    float ig[2], fg[2], n0v[2], m0[2];
#pragma unroll
    for (int dir = 0; dir < 2; ++dir) { ig[dir] = GT[row * 16 + dir * 8 + hh]; fg[dir] = GT[row * 16 + dir * 8 + 4 + hh]; }
    n0v[0] = NST[sidx0 * 64 + lane]; n0v[1] = NST[sidx1 * 64 + lane]; m0[0] = MENT[sidx0]; m0[1] = MENT[sidx1];
    asm volatile("s_waitcnt lgkmcnt(0)" ::: "memory");
    { const int rsub = lane >> 3, cq = lane & 7; const bf16* vp = U + (size_t)(row0 + rsub) * UW + U_MLV + hh * 64 + cq * 8;
#pragma unroll
      for (int i = 0; i < 8; ++i) *(u32x4*)(Vimg + img_off(i * 8 + rsub, cq)) = *(const u32x4*)(vp + (size_t)i * 8 * UW); }
    float btm[2], wi[2], emt[2];
#pragma unroll
    for (int dir = 0; dir < 2; ++dir) {
        const float lf = logsigmoidf(fg[dir]); const float bp = scan_add(lf, lane); const float tot = __shfl(bp, 63);
        const float bb = (dir == 0) ? bp : (tot - bp + lf);
        const float g = ig[dir] - bb; const float pm = (dir == 0) ? scan_max_up(g, lane) : scan_max_dn(g, lane);
        const float mt = bb + fmaxf(m0[dir], pm); wi[dir] = __expf(bb + m0[dir] - mt); btm[dir] = bb - mt; emt[dir] = __expf(-mt);
        gs[dir * 64 + lane] = g; n0s[dir * 64 + lane] = n0v[dir];
    }
    asm volatile("s_waitcnt lgkmcnt(0)" ::: "memory");
    const float* nw = P.in[I_MNW] + l * 256 + hh * 64;
#pragma unroll 1
    for (int th = 0; th < 2; ++th) {
        const int tl = 32 * th + r32;
        bf16x8 qf[4];
        f32x16 S[2]; S[0] = f32x16{}; S[1] = f32x16{};
        { bf16x8 kf[8];
#pragma unroll
          for (int ks = 0; ks < 4; ++ks)
#pragma unroll
              for (int sh = 0; sh < 2; ++sh) kf[2 * ks + sh] = *(const bf16x8*)(MLK + (size_t)(row0 + 32 * sh + r32) * 256 + hh * 64 + 16 * ks + 8 * hi);
#pragma unroll
          for (int ks = 0; ks < 4; ++ks) qf[ks] = *(const bf16x8*)(MLQ + (size_t)(row0 + tl) * 256 + hh * 64 + 16 * ks + 8 * hi);
#pragma unroll
          for (int ks = 0; ks < 4; ++ks)
#pragma unroll
              for (int sh = 0; sh < 2; ++sh) S[sh] = __builtin_amdgcn_mfma_f32_32x32x16_bf16(kf[2 * ks + sh], qf[ks], S[sh], 0, 0, 0); }
        f32x16 O[2]; O[0] = f32x16{}; O[1] = f32x16{};
#pragma unroll 1
        for (int dir = 0; dir < 2; ++dir) {
            const bf16* c0 = CST + (dir == 0 ? sidx0 : sidx1) * 4096;
            bf16x8 cfa[4];
#pragma unroll
            for (int ks = 0; ks < 4; ++ks) cfa[ks] = *(const bf16x8*)(c0 + r32 * 64 + 16 * ks + 8 * hi);
            const float btm_t = __shfl(dir == 0 ? btm[0] : btm[1], tl), wi_t = __shfl(dir == 0 ? wi[0] : wi[1], tl), emt_t = __shfl(dir == 0 ? emt[0] : emt[1], tl);
            float p[2][16]; float dsum = 0.f;
#pragma unroll
            for (int sh = 0; sh < 2; ++sh)
#pragma unroll
                for (int r = 0; r < 16; ++r) { const int sp = 32 * sh + crow(r, hi); const bool ok = (dir == 0) ? (sp <= tl) : (sp >= tl);
                    const float v = ok ? __expf(gs[dir * 64 + sp] + btm_t) * S[sh][r] : 0.f; p[sh][r] = v; dsum += v; }
            bf16x8 cfb[4];
#pragma unroll
            for (int ks = 0; ks < 4; ++ks) cfb[ks] = *(const bf16x8*)(c0 + (32 + r32) * 64 + 16 * ks + 8 * hi);
            float qn = 0.f;
#pragma unroll
            for (int ks = 0; ks < 4; ++ks) { float qv[8]; const u32x4 qq = __builtin_bit_cast(u32x4, qf[ks]); ML_UNPK(qq, qv);
#pragma unroll
                for (int q = 0; q < 8; ++q) qn += qv[q] * n0s[dir * 64 + 16 * ks + 8 * hi + q]; }
            const float den = swapadd(dsum) + wi_t * swapadd(qn);
            const float sc = __builtin_amdgcn_rcpf(fmaxf(fabsf(den), emt_t)), qsc = wi_t * sc;
            bf16x8 pf[4], qs[4];
#pragma unroll
            for (int ss = 0; ss < 4; ++ss) { const int sh = ss >> 1, r0 = 8 * (ss & 1); u32x4 w;
                w.x = cvtpk(p[sh][r0 + 0] * sc, p[sh][r0 + 1] * sc); w.y = cvtpk(p[sh][r0 + 2] * sc, p[sh][r0 + 3] * sc); w.z = cvtpk(p[sh][r0 + 4] * sc, p[sh][r0 + 5] * sc); w.w = cvtpk(p[sh][r0 + 6] * sc, p[sh][r0 + 7] * sc);
                pf[ss] = __builtin_bit_cast(bf16x8, w); }
#pragma unroll
            for (int ks = 0; ks < 4; ++ks) { float qv[8]; const u32x4 qq = __builtin_bit_cast(u32x4, qf[ks]); ML_UNPK(qq, qv); u32x4 w;
                w.x = cvtpk(qv[0] * qsc, qv[1] * qsc); w.y = cvtpk(qv[2] * qsc, qv[3] * qsc); w.z = cvtpk(qv[4] * qsc, qv[5] * qsc); w.w = cvtpk(qv[6] * qsc, qv[7] * qsc);
                qs[ks] = __builtin_bit_cast(bf16x8, w); }
#pragma unroll
            for (int ks = 0; ks < 4; ++ks) O[0] = __builtin_amdgcn_mfma_f32_32x32x16_bf16(cfa[ks], qs[ks], O[0], 0, 0, 0);
#pragma unroll
            for (int ss = 0; ss < 4; ++ss) O[0] = __builtin_amdgcn_mfma_f32_32x32x16_bf16(tr_frag(V3, 0, ss, lane), pf[ss], O[0], 0, 0, 0);
#pragma unroll
            for (int ks = 0; ks < 4; ++ks) O[1] = __builtin_amdgcn_mfma_f32_32x32x16_bf16(cfb[ks], qs[ks], O[1], 0, 0, 0);
#pragma unroll
            for (int ss = 0; ss < 4; ++ss) O[1] = __builtin_amdgcn_mfma_f32_32x32x16_bf16(tr_frag(V3, 1, ss, lane), pf[ss], O[1], 0, 0, 0);
        }
        float ss2 = 0.f;
#pragma unroll
        for (int ib = 0; ib < 2; ++ib)
#pragma unroll
            for (int r = 0; r < 16; ++r) ss2 += O[ib][r] * O[ib][r];
        const float rstd = rsqrtf(swapadd(ss2) * (1.f / 64.f) + EPS);
        const long orow = row0 + tl;
        u32x2 ogv[2][4]; f32x4 nwv[2][4];
#pragma unroll
        for (int ib = 0; ib < 2; ++ib)
#pragma unroll
            for (int g = 0; g < 4; ++g) { const int i0 = 32 * ib + 8 * g + 4 * hi; ogv[ib][g] = *(const u32x2*)(U + (size_t)orow * UW + U_MLO + hh * 64 + i0); nwv[ib][g] = *(const f32x4*)(nw + i0); }
        __builtin_amdgcn_sched_barrier(0);
#pragma unroll
        for (int ib = 0; ib < 2; ++ib)
#pragma unroll
            for (int g = 0; g < 4; ++g) { const int i0 = 32 * ib + 8 * g + 4 * hi; const u32x2 og = ogv[ib][g]; const f32x4 w = nwv[ib][g];
                const float o0 = sigmoidf(__uint_as_float(og.x << 16)) * O[ib][4 * g] * rstd * w.x, o1 = sigmoidf(__uint_as_float(og.x & 0xffff0000u)) * O[ib][4 * g + 1] * rstd * w.y;
                const float o2 = sigmoidf(__uint_as_float(og.y << 16)) * O[ib][4 * g + 2] * rstd * w.z, o3 = sigmoidf(__uint_as_float(og.y & 0xffff0000u)) * O[ib][4 * g + 3] * rstd * w.w;
                u32x2 ov; ov.x = cvtpk(o0, o1); ov.y = cvtpk(o2, o3);
                *(u32x2*)(MIX + (size_t)orow * DM + 256 + hh * 64 + i0) = ov; }
    }
}
#undef ML_UNPK
}
__device__ __forceinline__ void ph_ml_s1(Frame& F, int l) {
    const int gw = F.bid * NWAVES + F.wave, NGW = F.G * NWAVES;
    const bool stdg = (NGW == 2048);
    for (int k = 0; ; ++k) {
        const int it = stdg ? ((k == 0) ? gw : 2048 + (2047 - gw)) : gw + k * NGW;
        if (it >= 2048 + 256 || (stdg && k >= 2)) break;
        int bh, slot, dlo, dhi;
        if (it < 2048) { bh = it >> 6; slot = 4 + (it & 63); dlo = 0; dhi = 2; }
        else { const int r = it - 2048, q = r >> 1; dlo = r & 1; dhi = dlo + 1; bh = q >> 2; slot = q & 3; }
        ml::s1_item(F, l, bh >> 2, bh & 3, slot, F.lds + F.wave * 17408, dlo, dhi);
    }
}
__device__ __forceinline__ void ph_ml_s3(Frame& F, int l) {
    const int gw = F.bid * NWAVES + F.wave, NGW = F.G * NWAVES;
    const int s0 = (l == 0) ? 0 : 4, ns = 68 - s0;
    const bool stdg = (NGW == 2048);
    for (int k = 0; ; ++k) {
        const int it = stdg ? ((k == 0) ? gw : 2048 + (2047 - gw)) : gw + k * NGW;
        if (it >= 8 * 4 * ns || (stdg && k >= 2)) break;
        const int bh = it / ns, slot = s0 + it % ns; ml::s3_item(F, l, bh >> 2, bh & 3, slot, F.lds + F.wave * 10240);
    }
}

__device__ __forceinline__ void da_naive_item(Frame& F, int l, int b, int hh, long qrow0, int kt0, int kt1) {
    const CAS Params& P = *F.p;
    const bf16* U = WSP(bf16, WS_U); bf16* MIX = WSP(bf16, WS_HB);
    float* Qs = (float*)F.lds;
    float* Ks = Qs + 64 * 129;
    float* Vs = Ks + 64 * 129;
    float* Ps = Vs + 64 * 129;
    const int qi = F.tid >> 3, part = F.tid & 7;
    const float lam = WSP(float, WS_LAM)[l]; const float lam_init = 0.8f - 0.6f * expf(-0.3f * (float)l);
    for (int i = F.tid; i < 64 * 128; i += NTHREADS) { const int r = i >> 7, cc = i & 127; Qs[r * 129 + cc] = bf2f(U[(size_t)(qrow0 + r) * UW + U_DAQ + hh * 128 + cc]); }
    float M0 = -INFINITY, M1 = -INFINITY, L0 = 0.f, L1 = 0.f;
    for (int pass = 0; pass < 2; ++pass) {
        float o[16];
#pragma unroll
        for (int q = 0; q < 16; ++q) o[q] = 0.f;
        for (int kt = kt0; kt < kt1; ++kt) {
            const long krow0 = (kt < 64) ? ((long)b * SEQ + kt * 64) : (NLAT + (long)b * CTXL + (kt - 64) * 64);
            __syncthreads();
            for (int i = F.tid; i < 64 * 128; i += NTHREADS) { const int r = i >> 7, cc = i & 127; Ks[r * 129 + cc] = bf2f(U[(size_t)(krow0 + r) * UW + U_DAK + hh * 128 + cc]);
                if (pass) Vs[r * 129 + cc] = bf2f(U[(size_t)(krow0 + r) * UW + U_DAV + hh * 128 + cc]); }
            __syncthreads();
            float s0[8], s1[8];
#pragma unroll
            for (int kk = 0; kk < 8; ++kk) { s0[kk] = 0.f; s1[kk] = 0.f; }
            for (int d = 0; d < 64; ++d) { const float q0 = Qs[qi * 129 + d], q1 = Qs[qi * 129 + 64 + d];
#pragma unroll
                for (int kk = 0; kk < 8; ++kk) { const float* kr = Ks + (part * 8 + kk) * 129; s0[kk] += q0 * kr[d]; s1[kk] += q1 * kr[64 + d]; } }
            if (pass == 0) {
                float m0 = s0[0], m1 = s1[0];
#pragma unroll
                for (int kk = 1; kk < 8; ++kk) { m0 = fmaxf(m0, s0[kk]); m1 = fmaxf(m1, s1[kk]); }
                const float n0 = fmaxf(M0, m0), n1 = fmaxf(M1, m1);
                float a0 = 0.f, a1 = 0.f;
#pragma unroll
                for (int kk = 0; kk < 8; ++kk) { a0 += exp2f(s0[kk] - n0); a1 += exp2f(s1[kk] - n1); }
                L0 = L0 * exp2f(M0 - n0) + a0; L1 = L1 * exp2f(M1 - n1) + a1; M0 = n0; M1 = n1;
            } else {
#pragma unroll
                for (int kk = 0; kk < 8; ++kk) Ps[qi * 65 + part * 8 + kk] = exp2f(s0[kk] - M0) * L0 - lam * exp2f(s1[kk] - M1) * L1;
                __syncthreads();
                for (int k = 0; k < 64; ++k) { const float pv = Ps[qi * 65 + k]; const float* vr = Vs + k * 129 + part * 16;
#pragma unroll
                    for (int q = 0; q < 16; ++q) o[q] += pv * vr[q]; }
            }
        }
        if (pass == 0) {
#pragma unroll
            for (int sft = 1; sft < 8; sft <<= 1) {
                const float oM0 = __shfl_xor(M0, sft), oL0 = __shfl_xor(L0, sft), oM1 = __shfl_xor(M1, sft), oL1 = __shfl_xor(L1, sft);
                const float n0 = fmaxf(M0, oM0), n1 = fmaxf(M1, oM1);
                L0 = L0 * exp2f(M0 - n0) + oL0 * exp2f(oM0 - n0); L1 = L1 * exp2f(M1 - n1) + oL1 * exp2f(oM1 - n1); M0 = n0; M1 = n1;
            }
            L0 = 1.f / L0; L1 = 1.f / L1;
        } else {
            float ss = 0.f;
#pragma unroll
            for (int q = 0; q < 16; ++q) ss += o[q] * o[q];
            ss += __shfl_xor(ss, 1); ss += __shfl_xor(ss, 2); ss += __shfl_xor(ss, 4);
            const float rstd = rsqrtf(ss * (1.f / 128.f) + EPS) * (1.f - lam_init);
            const float* sw = P.in[I_SUBLN] + l * 128 + part * 16;
            bf16* dst = MIX + (size_t)(qrow0 + qi) * DM + 512 + hh * 128 + part * 16;
#pragma unroll
            for (int q = 0; q < 16; ++q) dst[q] = f2bf(o[q] * rstd * sw[q]);
        }
    }
    __syncthreads();
}

namespace da {
typedef short bf16x8 __attribute__((ext_vector_type(8)));
typedef short s16x4 __attribute__((ext_vector_type(4)));
typedef float f32x16 __attribute__((ext_vector_type(16)));
constexpr int KSLOT = 16384, VSLOT = 16384, VBASE = 65536, THR = 8;
__device__ __forceinline__ void glds16(const void* gsrc, unsigned lds_dst) { unsigned keep;
    asm volatile("s_mov_b32 %0, m0\n\ts_mov_b32 m0, %2\n\ts_nop 0\n\tglobal_load_lds_dwordx4 %1, off\n\ts_mov_b32 m0, %0" : "=&s"(keep) : "v"(gsrc), "s"(lds_dst) : "memory"); }
__device__ __forceinline__ float swapmax(float m) { auto rr = __builtin_amdgcn_permlane32_swap(__float_as_uint(m), __float_as_uint(m), false, false); return fmaxf(__uint_as_float(rr[0]), __uint_as_float(rr[1])); }
__device__ __forceinline__ float swapadd(float m) { auto rr = __builtin_amdgcn_permlane32_swap(__float_as_uint(m), __float_as_uint(m), false, false); return __uint_as_float(rr[0]) + __uint_as_float(rr[1]); }
template <int IMM> __device__ __forceinline__ void glds16s(const void* sbase, unsigned voff, unsigned lds_dst) { unsigned keep;
    asm volatile("s_mov_b32 %0, m0\n\ts_mov_b32 m0, %3\n\ts_nop 0\n\tglobal_load_lds_dwordx4 %1, %2 offset:%4\n\ts_mov_b32 m0, %0" : "=&s"(keep) : "v"(voff), "s"(sbase), "s"(lds_dst), "n"(IMM) : "memory"); }
#define DA_WAIT_BAR(N) asm volatile("s_waitcnt vmcnt(" #N ") lgkmcnt(0)\n\ts_barrier" ::: "memory")
typedef short v4i16_t __attribute__((ext_vector_type(4)));
template <int MW> __device__ __forceinline__ void unit_t(Frame& F, int l, int b_, int hh_, long qrow0_, int kt0_, int NT_) {
    const bf16* U = WSP(bf16, WS_U); bf16* MIX = WSP(bf16, WS_HB);
    const int b = __builtin_amdgcn_readfirstlane(b_), hh = __builtin_amdgcn_readfirstlane(hh_), kt0 = __builtin_amdgcn_readfirstlane(kt0_), NT = __builtin_amdgcn_readfirstlane(NT_);
    const long qrow0 = (long)__builtin_amdgcn_readfirstlane((int)qrow0_);
    int lane_ = F.lane; asm volatile("" : "+v"(lane_));
    constexpr int mw = MW;
    const int lane = lane_, r32 = lane & 31, hi = lane >> 5, wid = F.wave, rw = wid & 3;
    const unsigned lds0 = (unsigned)(uintptr_t)F.lds;
    typedef __attribute__((address_space(3))) const char* lds_cptr;
    const lds_cptr L3 = (lds_cptr)(__attribute__((address_space(3))) unsigned char*)F.lds;
    const unsigned kvo = (unsigned)(((lane >> 2) * UW + (((lane & 3) ^ ((lane >> 4) & 3)) * 8)) * 2), vvo = (unsigned)(((lane >> 2) * UW + (lane & 3) * 8) * 2);
    const char* const kwb = (const char*)(U + (size_t)((wid & 3) * 16) * UW + U_DAK + hh * 128 + (wid >> 2) * 32);
    const char* const vwb = (const char*)(U + (size_t)((2 * (wid & 1)) * 16) * UW + U_DAV + hh * 128 + (wid >> 1) * 32);
#define DA_KROW(kt) (((kt) < 64) ? ((long)b * SEQ + (long)(kt) * 64) : ((long)NLAT + (long)b * CTXL + (long)((kt) - 64) * 64))
#define DA_ISSUE(kt, ksl, vsl) do { const size_t ko_ = (size_t)DA_KROW(kt) * (UW * 2); const unsigned kd_ = lds0 + (unsigned)(ksl) * KSLOT + wid * 1024, vd_ = lds0 + VBASE + (unsigned)(vsl) * VSLOT + wid * 2048; \
        glds16s<0>(kwb + ko_, kvo, kd_); glds16s<128>(kwb + ko_, kvo, kd_ + 8192 - 128);         \
        glds16s<0>(vwb + ko_, vvo, vd_); glds16s<0>(vwb + ko_ + 16 * UW * 2, vvo, vd_ + 1024); } while (0)
    bf16x8 qf[4];
    { const bf16* qp = U + (size_t)(qrow0 + rw * 32 + r32) * UW + U_DAQ + hh * 128 + mw * 64 + hi * 8;
#pragma unroll
      for (int d0 = 0; d0 < 4; ++d0) qf[d0] = *(const bf16x8*)(qp + d0 * 16); }
    DA_ISSUE(kt0, 0, 0); DA_ISSUE(kt0 + 1, 1, 1); DA_ISSUE(kt0 + 2, 2, 2);
    f32x16 o[4];
#pragma unroll
    for (int d = 0; d < 4; ++d) o[d] = f32x16{};
    f32x16 negm = f32x16{};
    float lsum = 0.f;
    const int kfo = mw * 8192 + (r32 >> 4) * 1024 + (r32 & 15) * 64;
    const int ksw = (r32 >> 2) & 3;
    const int vfo = VBASE + (4 * hi + ((lane & 15) >> 2)) * 64 + ((lane >> 4) & 1) * 32 + (lane & 3) * 8;
#define DA_KFR(KF, KSL) do { const lds_cptr kb_ = L3 + (KSL) * KSLOT + kfo; \
        _Pragma("unroll") for (int d0 = 0; d0 < 4; ++d0) { const int co_ = (d0 >> 1) * 4096 + ((((2 * d0 + hi) & 3) ^ ksw) * 16); \
            KF[2 * d0] = *(const __attribute__((address_space(3))) bf16x8*)(kb_ + co_); KF[2 * d0 + 1] = *(const __attribute__((address_space(3))) bf16x8*)(kb_ + co_ + 2048); } } while (0)
#define DA_QKM(P0, P1, KF) do { _Pragma("unroll") for (int d0 = 0; d0 < 4; ++d0) { \
            P0 = __builtin_amdgcn_mfma_f32_32x32x16_bf16(KF[2 * d0], qf[d0], d0 == 0 ? negm : P0, 0, 0, 0); \
            P1 = __builtin_amdgcn_mfma_f32_32x32x16_bf16(KF[2 * d0 + 1], qf[d0], d0 == 0 ? negm : P1, 0, 0, 0); } } while (0)
#define DA_MAX3(a, b, c) ({ float r_; asm("v_max3_f32 %0, %1, %2, %3" : "=v"(r_) : "v"(a), "v"(b), "v"(c)); r_; })
#define DA_VFRAG(VB, D, S2) ({ const s16x4 lo_ = __builtin_bit_cast(s16x4, __builtin_amdgcn_ds_read_tr16_b64_v4i16((__attribute__((address_space(3))) v4i16_t*)((VB) + ((D) * 4 + (S2)) * 1024))); \
        const s16x4 hv_ = __builtin_bit_cast(s16x4, __builtin_amdgcn_ds_read_tr16_b64_v4i16((__attribute__((address_space(3))) v4i16_t*)((VB) + ((D) * 4 + (S2)) * 1024 + 512))); \
        (bf16x8){lo_[0], lo_[1], lo_[2], lo_[3], hv_[0], hv_[1], hv_[2], hv_[3]}; })
#define DA_PACK(PF, P0, P1) do { _Pragma("unroll") for (int s2 = 0; s2 < 2; ++s2) { u32x4 w0_, w1_; \
            w0_.x = cvtpk(P0[8 * s2 + 0], P0[8 * s2 + 1]); w0_.y = cvtpk(P0[8 * s2 + 2], P0[8 * s2 + 3]); w0_.z = cvtpk(P0[8 * s2 + 4], P0[8 * s2 + 5]); w0_.w = cvtpk(P0[8 * s2 + 6], P0[8 * s2 + 7]); \
            w1_.x = cvtpk(P1[8 * s2 + 0], P1[8 * s2 + 1]); w1_.y = cvtpk(P1[8 * s2 + 2], P1[8 * s2 + 3]); w1_.z = cvtpk(P1[8 * s2 + 4], P1[8 * s2 + 5]); w1_.w = cvtpk(P1[8 * s2 + 6], P1[8 * s2 + 7]); \
            PF[s2] = __builtin_bit_cast(bf16x8, w0_); PF[2 + s2] = __builtin_bit_cast(bf16x8, w1_); } } while (0)
#define DA_SBAR() __builtin_amdgcn_sched_barrier(0)
#define DA_LA 2
#define DA_PIN(x) asm volatile("" : "+v"(x))
#define DA_FADD(a, b) ({ float r_; asm("v_add_f32 %0, %1, %2" : "=v"(r_) : "v"(a), "v"(b)); r_; })
#define DA_PEL(A, B, e) (((e) < 16) ? A[(e) & 15] : B[(e) & 15])
#define DA_TR(p) __builtin_bit_cast(s16x4, __builtin_amdgcn_ds_read_tr16_b64_v4i16((__attribute__((address_space(3))) v4i16_t*)(p)))
#define DA_VOFF(i) ((((i) & 3) * 4 + ((i) >> 2)) * 1024)
#define DA_KLD(kb, j) (*(const __attribute__((address_space(3))) bf16x8*)((kb) + (((j) & 2) ? kfoB : kfoA) + ((j) >> 2) * 4096 + ((j) & 1) * 2048))
#define DA_MFMA(a, b, c) __builtin_amdgcn_mfma_f32_32x32x16_bf16(a, b, c, 0, 0, 0)
#define DA_KLD2(ka, kb, j) (*(const __attribute__((address_space(3))) bf16x8*)((((j) & 2) ? (kb) : (ka)) + ((j) >> 2) * 4096 + ((j) & 1) * 2048))
    const int kfoA = kfo + ((hi ^ ksw) * 16), kfoB = kfo + (((2 + hi) ^ ksw) * 16);
    f32x16 pA0, pA1, pB0, pB1;
    bf16x8 kf[8];
    if (mw == 0) __builtin_amdgcn_s_setprio(2);
    DA_WAIT_BAR(8);
#pragma unroll
    for (int j = 0; j < 8; ++j) kf[j] = DA_KLD(L3, j);
#pragma unroll
    for (int g = 0; g < 8; ++g) { if (g & 1) pA1 = DA_MFMA(kf[g], qf[g >> 1], (g == 1) ? negm : pA1); else pA0 = DA_MFMA(kf[g], qf[g >> 1], (g == 0) ? negm : pA0); }
    DA_WAIT_BAR(4);
    DA_ISSUE(kt0 + 3, 3, 3);
    kf[0] = DA_KLD(L3 + KSLOT, 0); kf[1] = DA_KLD(L3 + KSLOT, 1);
    { float rm = __builtin_fmaxf(pA0[0], pA1[0]);
#pragma unroll
      for (int r = 1; r < 16; ++r) rm = __builtin_fmaxf(rm, __builtin_fmaxf(pA0[r], pA1[r]));
      rm = swapmax(rm);
#pragma unroll
      for (int r = 0; r < 16; ++r) { negm[r] = -rm; pA0[r] = __builtin_amdgcn_exp2f(pA0[r] - rm); pA1[r] = __builtin_amdgcn_exp2f(pA1[r] - rm); } }
    int vprev = 0;
#define DA_PVM(i) o[(i) & 3] = DA_MFMA(((bf16x8){vlo_[(i) % DA_LA][0], vlo_[(i) % DA_LA][1], vlo_[(i) % DA_LA][2], vlo_[(i) % DA_LA][3], vhi_[(i) % DA_LA][0], vhi_[(i) % DA_LA][1], vhi_[(i) % DA_LA][2], vhi_[(i) % DA_LA][3]}), __builtin_bit_cast(bf16x8, pw_[(i) >> 2]), o[(i) & 3])
#define DA_VRD(i) do { if ((i) < 16) { vlo_[(i) % DA_LA] = DA_TR(vb_ + DA_VOFF((i) & 15)); vhi_[(i) % DA_LA] = DA_TR(vb_ + DA_VOFF((i) & 15) + 512); } } while (0)
#define DA_KRD(KREAD, j) do { if (KREAD) kf[(j) & 7] = DA_KLD2(kan_, kan_, (j) & 7); } while (0)
#define DA_STEP(C0, C1, P0, P1, TT, ISSUE, WAITSTMT, KREAD, BP, DP) do { \
        const int t_ = (TT); unsigned vbu_ = lds0 + vfo + vprev * VSLOT, kau_ = lds0 + kfoA + (t_ & 3) * KSLOT; \
        DA_PIN(vbu_); DA_PIN(kau_); unsigned kbu_ = kau_ ^ 32u; DA_PIN(kbu_);                     \
        const lds_cptr vb_ = (lds_cptr)(uintptr_t)(vbu_), ka_ = (lds_cptr)(uintptr_t)(kau_), kbb_ = (lds_cptr)(uintptr_t)(kbu_); \
        s16x4 vlo_[DA_LA], vhi_[DA_LA]; u32x4 pw_[4]; float sa1_ = 0.f; \
        DA_SBAR(); \
        _Pragma("unroll") for (int g = 0; g < 8; ++g) { \
            if (g & 1) C1 = DA_MFMA(kf[g], qf[g >> 1], (g == 1) ? negm : C1); else C0 = DA_MFMA(kf[g], qf[g >> 1], (g == 0) ? negm : C0); \
            if (g < 6) kf[(g + 2) & 7] = DA_KLD2(ka_, kbb_, (g + 2) & 7);                          \
            if (g >= 8 - DA_LA) DA_VRD(g - (8 - DA_LA)); \
            if (g == 0) { lsum = DA_FADD(lsum, DA_PEL(P0, P1, 0)); sa1_ = DA_FADD(DA_PEL(P0, P1, 1), DA_PEL(P0, P1, 3)); lsum = DA_FADD(lsum, DA_PEL(P0, P1, 2)); } \
            else { lsum = DA_FADD(lsum, DA_PEL(P0, P1, 4 * g)); sa1_ = DA_FADD(sa1_, DA_PEL(P0, P1, 4 * g + 1)); lsum = DA_FADD(lsum, DA_PEL(P0, P1, 4 * g + 2)); sa1_ = DA_FADD(sa1_, DA_PEL(P0, P1, 4 * g + 3)); } \
            pw_[g >> 1][(g & 1) * 2] = cvtpk(DA_PEL(P0, P1, 4 * g), DA_PEL(P0, P1, 4 * g + 1)); pw_[g >> 1][(g & 1) * 2 + 1] = cvtpk(DA_PEL(P0, P1, 4 * g + 2), DA_PEL(P0, P1, 4 * g + 3)); \
            DA_PIN(pw_[g >> 1]); DA_PIN(lsum); DA_PIN(sa1_); DA_SBAR(); } \
        lsum += sa1_; \
        if ((BP) == 0) { WAITSTMT; } \
          \
        DA_PVM(0); if ((ISSUE) && (DP) == 0) DA_ISSUE(kt0 + t_ + 3, (t_ + 3) & 3, (vprev == 0) ? 4 : vprev - 1); DA_VRD(DA_LA); DA_SBAR(); \
        DA_PVM(1); DA_VRD(1 + DA_LA); float rm_ = __builtin_fmaxf(C0[0], C1[0]); float rm2_ = DA_MAX3(C0[1], C1[1], C0[2]); rm_ = DA_MAX3(rm_, C1[2], C0[3]); rm2_ = DA_MAX3(rm2_, C0[4], C1[4]); rm_ = DA_MAX3(rm_, C0[5], C1[5]); \
        DA_PIN(rm_); DA_PIN(rm2_); DA_SBAR(); \
        DA_PVM(2); DA_VRD(2 + DA_LA); \
        _Pragma("unroll") for (int r = 6; r < 12; r += 2) { rm2_ = DA_MAX3(rm2_, C0[r], C1[r]); rm_ = DA_MAX3(rm_, C0[r + 1], C1[r + 1]); } \
        DA_PIN(rm_); DA_PIN(rm2_); DA_SBAR(); \
        DA_PVM(3); DA_VRD(3 + DA_LA); \
        _Pragma("unroll") for (int r = 12; r < 16; r += 2) { rm2_ = DA_MAX3(rm2_, C0[r], C1[r]); rm_ = DA_MAX3(rm_, C0[r + 1], C1[r + 1]); } \
        rm_ = DA_MAX3(rm_, rm2_, C1[3]); rm_ = swapmax(rm_); DA_PIN(rm_); DA_SBAR(); \
        bool resc_ = false; float fp_ = 1.f; \
        if (__any(rm_ > (float)THR)) { const float dl_ = fmaxf(rm_, 0.f), nm_ = negm[0] - dl_; fp_ = __builtin_amdgcn_exp2f(-dl_); lsum *= fp_; resc_ = true; \
            _Pragma("unroll") for (int r = 0; r < 16; ++r) { C0[r] -= dl_; C1[r] -= dl_; negm[r] = nm_; } } \
        unsigned kanu_ = lds0 + kfoA + ((t_ + 1) & 3) * KSLOT; DA_PIN(kanu_); const lds_cptr kan_ = (lds_cptr)(uintptr_t)(kanu_); \
        DA_SBAR(); \
        _Pragma("unroll") for (int i = 4; i < 16; ++i) { \
            if ((BP) == i) { WAITSTMT; }                                                             \
            DA_PVM(i); DA_VRD(i + DA_LA); if ((ISSUE) && (DP) == i) DA_ISSUE(kt0 + t_ + 3, (t_ + 3) & 3, (vprev == 0) ? 4 : vprev - 1); \
            if (i >= 14) DA_KRD(KREAD, i - 14); \
            _Pragma("unroll") for (int k = 0; k < ((i < 12) ? 3 : 2); ++k) { const int e = ((i < 12) ? (i - 4) * 3 : 24 + (i - 12) * 2) + k; \
                if (e < 16) C0[e & 15] = __builtin_amdgcn_exp2f(C0[e & 15]); else C1[e & 15] = __builtin_amdgcn_exp2f(C1[e & 15]); } \
            DA_PIN(C0); DA_PIN(C1); DA_SBAR(); } \
        if (resc_) { _Pragma("unroll") for (int d = 0; d < 4; ++d) _Pragma("unroll") for (int r = 0; r < 16; ++r) o[d][r] *= fp_; } \
        vprev = (vprev == 4) ? 0 : vprev + 1; \
    } while (0)
    int t = 1;
    constexpr int BP_ = (MW == 0) ? 0 : 8, DP_ = (MW == 0) ? 0 : 12;
    for (; t + 4 < NT; t += 2) {
        DA_STEP(pB0, pB1, pA0, pA1, t, true, DA_WAIT_BAR(4), true, BP_, DP_);
        DA_STEP(pA0, pA1, pB0, pB1, t + 1, true, DA_WAIT_BAR(4), true, BP_, DP_);
    }
    DA_STEP(pB0, pB1, pA0, pA1, t, false, DA_WAIT_BAR(4), true, BP_, DP_);
    DA_STEP(pA0, pA1, pB0, pB1, t + 1, false, DA_WAIT_BAR(0), true, BP_, DP_);
    DA_STEP(pB0, pB1, pA0, pA1, t + 2, false, DA_WAIT_BAR(0), false, BP_, DP_);
    { float sa = 0.f;
#pragma unroll
      for (int r = 0; r < 16; ++r) sa += pB0[r] + pB1[r];
      lsum += sa;
      bf16x8 pfp[4];
#pragma unroll
      for (int s2 = 0; s2 < 2; ++s2) { u32x4 w0_, w1_;
          w0_.x = cvtpk(pB0[8 * s2 + 0], pB0[8 * s2 + 1]); w0_.y = cvtpk(pB0[8 * s2 + 2], pB0[8 * s2 + 3]); w0_.z = cvtpk(pB0[8 * s2 + 4], pB0[8 * s2 + 5]); w0_.w = cvtpk(pB0[8 * s2 + 6], pB0[8 * s2 + 7]);
          w1_.x = cvtpk(pB1[8 * s2 + 0], pB1[8 * s2 + 1]); w1_.y = cvtpk(pB1[8 * s2 + 2], pB1[8 * s2 + 3]); w1_.z = cvtpk(pB1[8 * s2 + 4], pB1[8 * s2 + 5]); w1_.w = cvtpk(pB1[8 * s2 + 6], pB1[8 * s2 + 7]);
          pfp[s2] = __builtin_bit_cast(bf16x8, w0_); pfp[2 + s2] = __builtin_bit_cast(bf16x8, w1_); }
      unsigned vbu = lds0 + vfo + vprev * VSLOT; DA_PIN(vbu);
      const lds_cptr vb = (lds_cptr)(uintptr_t)(vbu);
#pragma unroll
      for (int s2 = 0; s2 < 4; ++s2)
#pragma unroll
          for (int d = 0; d < 4; ++d) o[d] = __builtin_amdgcn_mfma_f32_32x32x16_bf16(DA_VFRAG(vb, d, s2), pfp[s2], o[d], 0, 0, 0); }
#undef DA_STEP
#undef DA_PVM
#undef DA_VRD
#undef DA_KRD
#undef DA_SBAR
#undef DA_LA
#undef DA_PIN
#undef DA_FADD
#undef DA_PEL
#undef DA_TR
#undef DA_VOFF
#undef DA_KLD
#undef DA_KLD2
#undef DA_MFMA
#undef DA_KFR
#undef DA_QKM
#undef DA_MAX3
#undef DA_VFRAG
#undef DA_PACK
    __builtin_amdgcn_s_setprio(0);
    {
        int lane_e = F.lane; asm volatile("" : "+v"(lane_e));
        const int lane = lane_e, r32 = lane & 31, hi = lane >> 5;
        const float lam = WSP(float, WS_LAM)[l]; const float lam_init = 0.8f - 0.6f * __expf(-0.3f * (float)l);
        const float inv = ((mw == 0) ? 1.f : lam) / swapadd(lsum);
        asm volatile("s_waitcnt lgkmcnt(0)\n\ts_barrier" ::: "memory");
        float* X = (float*)F.lds + rw * 4096 + lane;
        if (mw == 1) {
#pragma unroll
            for (int d = 0; d < 4; ++d)
#pragma unroll
                for (int r = 0; r < 16; ++r) X[(d * 16 + r) * 64] = o[d][r] * inv;
        }
        asm volatile("s_waitcnt lgkmcnt(0)\n\ts_barrier" ::: "memory");
        if (mw == 0) {
            float ss = 0.f;
#pragma unroll
            for (int d = 0; d < 4; ++d)
#pragma unroll
                for (int r = 0; r < 16; ++r) { const float v = o[d][r] * inv - X[(d * 16 + r) * 64]; o[d][r] = v; ss += v * v; }
            ss = swapadd(ss);
            const float rstd = rsqrtf(ss * (1.f / 128.f) + EPS) * (1.f - lam_init);
            const float* sw = F.p->in[I_SUBLN] + l * 128;
            bf16* orow = MIX + (size_t)(qrow0 + rw * 32 + r32) * DM + 512 + hh * 128;
            f32x4 swv[4][4];
#pragma unroll
            for (int d = 0; d < 4; ++d)
#pragma unroll
                for (int g = 0; g < 4; ++g) swv[d][g] = *(const f32x4*)(sw + d * 32 + 8 * g + 4 * hi);
            __builtin_amdgcn_sched_barrier(0);
#pragma unroll
            for (int d = 0; d < 4; ++d)
#pragma unroll
                for (int g = 0; g < 4; ++g) { const int dd = d * 32 + 8 * g + 4 * hi; const f32x4 w = swv[d][g];
                    u32x2 ov; ov.x = cvtpk(o[d][4 * g] * rstd * w.x, o[d][4 * g + 1] * rstd * w.y); ov.y = cvtpk(o[d][4 * g + 2] * rstd * w.z, o[d][4 * g + 3] * rstd * w.w);
                    *(u32x2*)(orow + dd) = ov; }
        }
    }
    asm volatile("s_waitcnt vmcnt(0) lgkmcnt(0)\n\ts_barrier" ::: "memory");
#undef DA_KROW
#undef DA_ISSUE
}
__device__ __forceinline__ void unit(Frame& F, int l, int b, int hh, long qrow0, int kt0, int NT) {
    if (F.wave < 4) unit_t<0>(F, l, b, hh, qrow0, kt0, NT); else unit_t<1>(F, l, b, hh, qrow0, kt0, NT);
}
#undef DA_WAIT_BAR
}
__device__ __forceinline__ void ph_attn_fast(Frame& F, int l) {
    const int vcu = (F.G % 8 == 0) ? (F.bid % 8) * (F.G / 8) + F.bid / 8 : F.bid;
    const int nu = 1024 + ((l == 0) ? 64 : 0);
    for (int u = vcu; u < nu; u += F.G) {
        if (u < 1024) { const int bh = u >> 5, qb = u & 31, b = bh >> 2, hh = bh & 3; da::unit(F, l, b, hh, (long)b * SEQ + qb * 128, 0, 68); }
        else { const int r = u - 1024, bh = r >> 1, b = bh >> 2, hh = bh & 3; da::unit(F, l, b, hh, (long)NLAT + (long)b * CTXL + (r & 1) * 128, 64, 4); }
    }
}

__device__ __forceinline__ void ph_mixers_naive(Frame& F, int l) {
    if (FAST_HYENA) { for (int rep = 0; rep < DUP(1); ++rep) for (int c = F.bid; c < 256; c += F.G) hy::unit(F, l, c); }
    else for (int it = F.bid; it < 2048; it += F.G) hy_naive_item(F, l, it >> 3, it & 7, SEQ, WSP(float, WS_H2L) + (size_t)l * 4096 * 64, WSP(bf16, WS_HYV), WSP(bf16, WS_HYX1), WSP(bf16, WS_HYX2), WSP(bf16, WS_HYY));
    if (l == 0) for (int rep = 0; rep < DUP(2); ++rep) for (int it = F.bid; it < 2048; it += F.G) hy_naive_item(F, l, it >> 3, it & 7, CTXL, WSP(float, WS_H2C), WSP(bf16, WS_HYVC), WSP(bf16, WS_HYX1C), WSP(bf16, WS_HYX2C), WSP(bf16, WS_HYYC));
    if (FAST_MLSTM) { for (int sq = F.bid; sq < 64; sq += F.G) ml::s2_item(F, sq, F.wave); }
    else for (int it = F.bid; it < 64; it += F.G) ml_naive_item(F, it >> 3, (it >> 1) & 3, it & 1);
    if (FAST_ATTN) { for (int rep = 0; rep < DUP(0); ++rep) ph_attn_fast(F, l); return; }
    for (int it = F.bid; it < 2048; it += F.G) { const int b = it >> 8, hh = (it >> 6) & 3, qb = it & 63; da_naive_item(F, l, b, hh, (long)b * SEQ + qb * 64, 0, 68); }
    if (l == 0) for (int it = F.bid; it < 128; it += F.G) { const int b = it >> 4, hh = (it >> 2) & 3, qb = it & 3; da_naive_item(F, l, b, hh, NLAT + (long)b * CTXL + qb * 64, 64, 68); }
}

__device__ __forceinline__ void hyc_unit(Frame& F, int c) {
    const CAS Params& P = *F.p;
    float* T = (float*)F.lds;
    float* z = T + 512;
    float* red = z + 2048;
    const bf16* V = WSP(bf16, WS_HYVC) + (size_t)c * 8 * CTXL; const bf16* X1 = WSP(bf16, WS_HYX1C) + (size_t)c * 8 * CTXL; const bf16* X2 = WSP(bf16, WS_HYX2C) + (size_t)c * 8 * CTXL; bf16* Y = WSP(bf16, WS_HYYC) + (size_t)c * 8 * CTXL;
    for (int i = F.tid; i < 2048; i += NTHREADS) z[i] = bf2f(V[i]);
    const int b = F.tid >> 6, tl = F.tid & 63;
    for (int o = 0; o < 2; ++o) {
        hy_taps(F, 0, o, c, CTXL, WSP(float, WS_H2C), T, red);
        const float dd = P.in[I_HBD][o * 256 + c]; const bf16* G = (o == 0) ? X1 : X2;
        float res[4] = {0.f, 0.f, 0.f, 0.f};
        for (int sI = 0; sI < CTXL; ++sI) { const float zs = z[b * CTXL + sI];
#pragma unroll
            for (int q = 0; q < 4; ++q) res[q] += T[tl + 64 * q - sI + CTXL] * zs; }
#pragma unroll
        for (int q = 0; q < 4; ++q) { const int t = tl + 64 * q; res[q] = bf2f(G[b * CTXL + t]) * (res[q] + dd * z[b * CTXL + t]); }
        __syncthreads();
#pragma unroll
        for (int q = 0; q < 4; ++q) { const int t = tl + 64 * q; if (o == 0) z[b * CTXL + t] = bf2f(f2bf(res[q])); else Y[b * CTXL + t] = f2bf(res[q]); }
        __syncthreads();
    }
}
__device__ __forceinline__ void conv_moe_item(Frame& F, int l, int k) {
    float* scr = (float*)(F.lds) + F.wave * (64 * 33);
    const float* w1 = F.p->in[I_W1] + (size_t)l * NEXP * DM * FF; const float* w3 = F.p->in[I_W3] + (size_t)l * NEXP * DM * FF; const float* w2 = F.p->in[I_W2] + (size_t)l * NEXP * FF * DM;
    bf16* UPT = WSP(bf16, WS_UPT); bf16* DNT = WSP(bf16, WS_DNT);
    const int it = k * 8 + F.wave;
    const int which = it / 8192, r = it % 8192, e = r / 256, q = r % 256;
    if (which < 2) { const int kb = q / 16, nb = q % 16, n0 = nb * 32, rd = (n0 >> 7) * 256 + (n0 & 127) + which * 128;
        tr_item((which ? w3 : w1) + (size_t)e * DM * FF, FF, kb * 64, n0, 32, UPT + (size_t)e * 1024 * 1024, 1024, rd, scr, F.lane); }
    else { const int kb = q / 32, nb = q % 32;
        tr_item(w2 + (size_t)e * FF * DM, DM, kb * 64, nb * 32, 32, DNT + (size_t)e * 1024 * 512, 512, nb * 32, scr, F.lane); }
    __syncthreads();
}
struct TrP { const float* src; int ldw; bf16* dst; int ldt; };
__device__ __forceinline__ TrP conv_decode(Frame& F, int l, int k) {
    const float* w1 = F.p->in[I_W1] + (size_t)l * NEXP * DM * FF; const float* w3 = F.p->in[I_W3] + (size_t)l * NEXP * DM * FF; const float* w2 = F.p->in[I_W2] + (size_t)l * NEXP * FF * DM;
    bf16* UPT = WSP(bf16, WS_UPT); bf16* DNT = WSP(bf16, WS_DNT);
    const int it = k * 8 + F.wave; const int which = it / 8192, r = it % 8192, e = r / 256, q = r % 256; TrP t;
    if (which < 2) { const int kb = q / 16, nb = q % 16, n0 = nb * 32, rd = (n0 >> 7) * 256 + (n0 & 127) + which * 128;
        t.src = (which ? w3 : w1) + (size_t)e * DM * FF + (size_t)(kb * 64) * FF + n0; t.ldw = FF; t.dst = UPT + (size_t)e * 1024 * 1024 + (size_t)rd * 1024 + kb * 64; t.ldt = 1024; }
    else { const int kb = q / 32, nb = q % 32; t.src = w2 + (size_t)e * FF * DM + (size_t)(kb * 64) * DM + nb * 32; t.ldw = DM; t.dst = DNT + (size_t)e * 1024 * 512 + (size_t)(nb * 32) * 512 + kb * 64; t.ldt = 512; }
    return t;
}
__device__ __forceinline__ void conv_moe_quad(Frame& F, int l, int k4) {
    float* scr = (float*)(F.lds) + F.wave * (64 * 33);
    const int lane = F.lane, kr = lane >> 3, c4 = (lane & 7) * 4, c = lane & 7;
    TrP p = conv_decode(F, l, k4);
    f32x4 v[8];
#pragma unroll
    for (int i = 0; i < 8; ++i) v[i] = *(const f32x4*)(p.src + (size_t)(8 * i + kr) * p.ldw + c4);
#pragma unroll 1
    for (int j = 0; j < 4; ++j) {
#pragma unroll
        for (int i = 0; i < 8; ++i) { float* d = scr + (8 * i + kr) * 33 + c4; d[0] = v[i].x; d[1] = v[i].y; d[2] = v[i].z; d[3] = v[i].w; }
        asm volatile("s_waitcnt lgkmcnt(0)" ::: "memory");
        const TrP pn = conv_decode(F, l, k4 + ((j < 3) ? j + 1 : j));
        if (j < 3) {
#pragma unroll
            for (int i = 0; i < 8; ++i) v[i] = *(const f32x4*)(pn.src + (size_t)(8 * i + kr) * pn.ldw + c4); }
        __builtin_amdgcn_sched_barrier(0);
#pragma unroll
        for (int j4 = 0; j4 < 4; ++j4) { const int n = (lane >> 3) + 8 * j4; const float* sp = scr + (8 * c) * 33 + n;
            u32x4 o; o.x = pk2(sp[0 * 33], sp[1 * 33]); o.y = pk2(sp[2 * 33], sp[3 * 33]); o.z = pk2(sp[4 * 33], sp[5 * 33]); o.w = pk2(sp[6 * 33], sp[7 * 33]);
            *(u32x4*)(p.dst + (size_t)n * p.ldt + 8 * c) = o; }
        asm volatile("s_waitcnt lgkmcnt(0)" ::: "memory");
        p = pn;
    }
    __syncthreads();
}
__device__ __forceinline__ int q_pull(Frame& F, unsigned* heads, int ty, int nper, int myx, int& qoff) {
    volatile int* slotw = (volatile int*)(F.lds + LDS_CTL_OFF + 64);
    if (F.wave == 0) {
        int res = -1;
        unsigned own = 0u; if (F.lane == 0) own = __hip_atomic_fetch_add(heads + (ty * 8 + myx) * 64, 1u, __ATOMIC_RELAXED, __HIP_MEMORY_SCOPE_AGENT);
        for (int tries = 0; tries < 64; ++tries) {
            const int q = (myx + (F.lane & 7)) & 7;
            const unsigned h = __hip_atomic_load(heads + (ty * 8 + q) * 64, __ATOMIC_RELAXED, __HIP_MEMORY_SCOPE_AGENT);
            if (tries == 0) { const int o_ = __builtin_amdgcn_readfirstlane((int)own); if (o_ >= 0 && o_ < nper) { res = myx * 65536 + o_; break; } }
            const unsigned long long live = __ballot(F.lane < 8 && (int)h < nper);
            if (live == 0ull) break;
            const int pick = __builtin_ctzll(live);
            const int qp = (myx + pick) & 7;
            unsigned idx = 0u;
            if (F.lane == 0) idx = __hip_atomic_fetch_add(heads + (ty * 8 + qp) * 64, 1u, __ATOMIC_RELAXED, __HIP_MEMORY_SCOPE_AGENT);
            idx = (unsigned)__builtin_amdgcn_readfirstlane((int)idx);
            if ((int)idx < nper) { res = qp * 65536 + (int)idx; break; }
        }
        if (F.lane == 0) { slotw[0] = res; slotw[1] = qoff; }
    }
    __syncthreads();
    const int res = slotw[0];
    __syncthreads();
    return res;
}
__device__ __forceinline__ void ph_mixers_dyn(Frame& F0, int l, unsigned char* lds) {
    Frame F = F0; const int g_wave0 = F0.wave;
#define mkframe(L) mkframe_(L, g_wave0)
    unsigned* heads = WSP(unsigned, WS_CTL) + CW_Q + l * 4096;
    const int myx = (int)(xb_xcc_id() & 7u);
    const bool convfirst = ((F.bid >> 3) & 1) == 0;
#define MIX_CONV_BURST(NP) do { int qoff_ = 0; for (int np_ = 0; np_ < (NP); ++np_) { const int r = q_pull(F, heads, 5, 96, myx, qoff_); if (r < 0) break; const int k4 = ((r >> 16) * 96 + (r & 65535)) * 4; \
            conv_moe_quad(F, l, k4); } } while (0)
    if (convfirst) { bool s2_ = false; { int qoff = 0; const int r = q_pull(F, heads, 0, 8, myx, qoff); if (r >= 0) { ml::s2_item(F, (r >> 16) * 8 + (r & 65535), F.wave); s2_ = true; } } F = mkframe(lds); MIX_CONV_BURST(s2_ ? 2 : 3); F = mkframe(lds); }
    { int qoff = 0; for (;;) { const int r = q_pull(F, heads, 1, 32, myx, qoff); if (r < 0) break; hy::unit(F, l, (r >> 16) * 32 + (r & 65535)); } }
    F = mkframe(lds);
    if (!convfirst) { bool s2_ = false; { int qoff = 0; const int r = q_pull(F, heads, 0, 8, myx, qoff); if (r >= 0) { ml::s2_item(F, (r >> 16) * 8 + (r & 65535), F.wave); s2_ = true; } } F = mkframe(lds); MIX_CONV_BURST(s2_ ? 2 : 3); F = mkframe(lds); }
    { int qoff = 0; for (;;) { const int r = q_pull(F, heads, 2, 128, myx, qoff); if (r < 0) break; const int x = r >> 16, j = r & 65535, bh = x + 8 * (j >> 5), qb = j & 31, b = bh >> 2, hh = bh & 3;
          da::unit(F, l, b, hh, (long)b * SEQ + qb * 128, 0, 68); } }
    if (l == 0) {
        F = mkframe(lds);
        { int qoff = 0; for (;;) { const int r = q_pull(F, heads, 3, 8, myx, qoff); if (r < 0) break; const int rr = (r >> 16) * 8 + (r & 65535), bh = rr >> 1, b = bh >> 2, hh = bh & 3;
              da::unit(F, l, b, hh, (long)NLAT + (long)b * CTXL + (rr & 1) * 128, 64, 4); } }
        F = mkframe(lds);
        { int qoff = 0; for (;;) { const int r = q_pull(F, heads, 4, 32, myx, qoff); if (r < 0) break; hyc_unit(F, (r >> 16) * 32 + (r & 65535)); } }
    }
    F = mkframe(lds);
    { int qoff = 0; for (;;) { const int r = q_pull(F, heads, 0, 8, myx, qoff); if (r < 0) break; ml::s2_item(F, (r >> 16) * 8 + (r & 65535), F.wave); } }
    F = mkframe(lds);
    { int qoff = 0; for (;;) { const int r = q_pull(F, heads, 5, 96, myx, qoff); if (r < 0) break; const int k4 = ((r >> 16) * 96 + (r & 65535)) * 4;
          conv_moe_quad(F, l, k4); } }
#undef MIX_CONV_BURST
#undef mkframe
}

__device__ __forceinline__ void ph_assemble(Frame& F, int l) {
    const CAS Params& P = *F.p;
    bf16* MIX = WSP(bf16, WS_HB);
    bf16* S = (bf16*)F.lds;
    const int nitems = 8 * 64 * 4 + ((l == 0) ? 8 * 4 * 4 : 0);
    for (int it0 = F.bid; it0 < nitems; it0 += 4 * F.G) {
#pragma unroll
        for (int q4 = 0; q4 < 4; ++q4) { const int it = it0 + q4 * F.G;
            if (it < nitems) { int seq, tb, cbk, Ls; const bf16* Y;
                if (it < 2048) { seq = it >> 8; tb = (it >> 2) & 63; cbk = it & 3; Ls = SEQ; Y = WSP(bf16, WS_HYY); }
                else { const int r = it - 2048; seq = r >> 4; tb = (r >> 2) & 3; cbk = r & 3; Ls = CTXL; Y = WSP(bf16, WS_HYYC); }
                const int c = F.tid >> 3, tq = (F.tid & 7) * 8;
                *(u32x4*)(S + q4 * (64 * 72) + c * 72 + tq) = *(const u32x4*)(Y + ((size_t)(cbk * 64 + c) * 8 + seq) * Ls + tb * 64 + tq); } }
        __syncthreads();
#pragma unroll
        for (int q4 = 0; q4 < 4; ++q4) { const int it = it0 + q4 * F.G;
            if (it < nitems) { int seq, tb, cbk; long rbase;
                if (it < 2048) { seq = it >> 8; tb = (it >> 2) & 63; cbk = it & 3; rbase = (long)seq * SEQ; }
                else { const int r = it - 2048; seq = r >> 4; tb = (r >> 2) & 3; cbk = r & 3; rbase = NLAT + (long)seq * CTXL; }
                const int t = F.tid >> 3, cq = (F.tid & 7) * 8; unsigned short v[8];
#pragma unroll
                for (int q = 0; q < 8; ++q) v[q] = S[q4 * (64 * 72) + (cq + q) * 72 + t];
                u32x4 ov; ov.x = v[0] | ((unsigned)v[1] << 16); ov.y = v[2] | ((unsigned)v[3] << 16); ov.z = v[4] | ((unsigned)v[5] << 16); ov.w = v[6] | ((unsigned)v[7] << 16);
                *(u32x4*)(MIX + (size_t)(rbase + tb * 64 + t) * DM + cbk * 64 + cq) = ov; } }
        __syncthreads();
    }
    if (FAST_MLSTM) { __syncthreads(); ph_ml_s3(F, l); return; }
    const bf16* H0 = WSP(bf16, WS_MLH); const bf16* H1 = H0 + (size_t)MTOT * 256; const bf16* U = WSP(bf16, WS_U);
    const float* nw = P.in[I_MNW] + l * 256;
    const int gw = F.bid * NWAVES + F.wave, NGW = F.G * NWAVES;
    const int nrows = (l == 0) ? MTOT : NLAT;
    for (int row = gw; row < nrows; row += NGW) {
        const int c = 4 * F.lane;
        const u32x2 a = *(const u32x2*)(H0 + (size_t)row * 256 + c), b = *(const u32x2*)(H1 + (size_t)row * 256 + c), og = *(const u32x2*)(U + (size_t)row * UW + U_MLO + c);
        float h[4] = { __uint_as_float(a.x << 16) + __uint_as_float(b.x << 16), __uint_as_float(a.x & 0xffff0000u) + __uint_as_float(b.x & 0xffff0000u),
                       __uint_as_float(a.y << 16) + __uint_as_float(b.y << 16), __uint_as_float(a.y & 0xffff0000u) + __uint_as_float(b.y & 0xffff0000u) };
        const float ov[4] = { __uint_as_float(og.x << 16), __uint_as_float(og.x & 0xffff0000u), __uint_as_float(og.y << 16), __uint_as_float(og.y & 0xffff0000u) };
        float ss = h[0] * h[0] + h[1] * h[1] + h[2] * h[2] + h[3] * h[3];
        ss += __shfl_xor(ss, 1); ss += __shfl_xor(ss, 2); ss += __shfl_xor(ss, 4); ss += __shfl_xor(ss, 8);
        const float rstd = rsqrtf(ss * (1.f / 64.f) + EPS);
        float r[4];
#pragma unroll
        for (int q = 0; q < 4; ++q) r[q] = sigmoidf(ov[q]) * h[q] * rstd * nw[c + q];
        u32x2 o2; o2.x = pk2(r[0], r[1]); o2.y = pk2(r[2], r[3]);
        *(u32x2*)(MIX + (size_t)row * DM + 256 + c) = o2;
    }
}

template <bool DRY>
__device__ __forceinline__ void ph_norm2_router(Frame& F, int l) {
    const CAS Params& P = *F.p;
    float* Wr = (float*)F.lds;
    int* lcnt = (int*)(F.lds + 147456);
    int* rec = lcnt + 32;
    { const float* wg = P.in[I_WG] + (size_t)l * DM * 4; const float* we = P.in[I_WE] + (size_t)l * DM * 32;
#pragma unroll
      for (int q = 0; q < 2; ++q) { const int k = F.tid + q * NTHREADS; const f32x4 v = *(const f32x4*)(wg + 4 * k); Wr[k] = v.x; Wr[DM + k] = v.y; Wr[2 * DM + k] = v.z; Wr[3 * DM + k] = v.w; }
#pragma unroll 4
      for (int q = 0; q < 16; ++q) { const int i4 = F.tid + q * NTHREADS; const int k = i4 >> 3, n4 = (i4 & 7) * 4; const f32x4 v = *(const f32x4*)(we + 4 * i4);
          Wr[(4 + n4) * DM + k] = v.x; Wr[(5 + n4) * DM + k] = v.y; Wr[(6 + n4) * DM + k] = v.z; Wr[(7 + n4) * DM + k] = v.w; }
      if (F.tid < 32) lcnt[F.tid] = 0; }
    __syncthreads();
    const float* mods = WSP(float, WS_MODS); float* XC = WSP(float, WS_XC); bf16* HB = WSP(bf16, WS_HB);
    int* EXPID = WSP(int, WS_EXPID); float* GATEV = WSP(float, WS_GATEV); int* LIST = WSP(int, WS_LIST); unsigned* CNT = WSP(unsigned, WS_CTL) + CW_CNT + l * 32 * CNT_STRIDE;
    const float* bg = P.in[I_BG] + l * 4; const float* be = P.in[I_BE] + l * 32; const float* nw = P.in[I_N2W] + l * DM;
    const int gw = F.bid * NWAVES + F.wave, NGW = F.G * NWAVES;
    const int nrows = (l == 0) ? MTOT : NLAT;
    int kk = 0;
    f32x4 nwv[4];
#pragma unroll
    for (int j = 0; j < 4; ++j) nwv[j] = *(const f32x4*)(nw + 256 * j + 4 * F.lane);
    u32x2 xn[4];
    if (gw < nrows) { const bf16* X0 = xrow_ptr(P.out, F.ws, gw);
#pragma unroll
        for (int j = 0; j < 4; ++j) xn[j] = *(const u32x2*)(X0 + 256 * j + 4 * F.lane); }
    for (int row = gw; row < nrows; row += NGW, ++kk) {
        const int bsel = row < NLAT ? (row >> 12) : 8;
        const float* sh = mods + (size_t)(l * 9 + bsel) * 6144 + 3 * DM; const float* sc = sh + DM;
        u32x2 xc[4];
#pragma unroll
        for (int j = 0; j < 4; ++j) xc[j] = xn[j];
        if (row + NGW < nrows) { const bf16* X1 = xrow_ptr(P.out, F.ws, row + NGW);
#pragma unroll
            for (int j = 0; j < 4; ++j) xn[j] = *(const u32x2*)(X1 + 256 * j + 4 * F.lane); }
        f32x4 s1v[4], s0v[4];
#pragma unroll
        for (int j = 0; j < 4; ++j) { s1v[j] = *(const f32x4*)(sc + 256 * j + 4 * F.lane); s0v[j] = *(const f32x4*)(sh + 256 * j + 4 * F.lane); }
        f32x4 v[4]; float ss = 0.f;
#pragma unroll
        for (int j = 0; j < 4; ++j) { const u32x2 xv = xc[j]; v[j].x = __uint_as_float(xv.x << 16); v[j].y = __uint_as_float(xv.x & 0xffff0000u); v[j].z = __uint_as_float(xv.y << 16); v[j].w = __uint_as_float(xv.y & 0xffff0000u); ss += (v[j].x * v[j].x + v[j].y * v[j].y) + (v[j].z * v[j].z + v[j].w * v[j].w); }
        const float rstd = rsqrtf(wave_sum(ss) * (1.f / DM) + EPS);
#pragma unroll
        for (int j = 0; j < 4; ++j) { const int c = 256 * j + 4 * F.lane; const f32x4 w = nwv[j], s1 = s1v[j], s0 = s0v[j];
            v[j] = v[j] * rstd * w * (s1 + 1.f) + s0;
            u32x2 o; o.x = pk2(v[j].x, v[j].y); o.y = pk2(v[j].z, v[j].w); *(u32x2*)(HB + (size_t)row * DM + c) = o; }
        float g[4];
        { float a[4];
#pragma unroll
          for (int n = 0; n < 4; ++n) { a[n] = 0.f;
#pragma unroll
              for (int j = 0; j < 4; ++j) { const f32x4 w = *(const f32x4*)(Wr + n * DM + 256 * j + 4 * F.lane); a[n] += (v[j].x * w.x + v[j].y * w.y) + (v[j].z * w.z + v[j].w * w.w); } }
          { const bool up = (F.lane & 32) != 0;
#pragma unroll
            for (int i = 0; i < 2; ++i) { const float snd = up ? a[i] : a[i + 2]; const float rcv = __shfl_xor(snd, 32); a[i] = (up ? a[i + 2] : a[i]) + rcv; } }
          { const bool up = (F.lane & 16) != 0; const float snd = up ? a[0] : a[1]; const float rcv = __shfl_xor(snd, 16); a[0] = (up ? a[1] : a[0]) + rcv; }
#pragma unroll
          for (int o = 8; o >= 1; o >>= 1) a[0] += __shfl_xor(a[0], o);
#pragma unroll
          for (int n = 0; n < 4; ++n) g[n] = __shfl(a[0], n * 16) + bg[n]; }
        int gi = 0; float gm = g[0];
#pragma unroll
        for (int n = 1; n < 4; ++n) if (g[n] > gm) { gm = g[n]; gi = n; }
        float gs = 0.f;
#pragma unroll
        for (int n = 0; n < 4; ++n) gs += __expf(g[n] - gm);
        const float gwt = __builtin_amdgcn_rcpf(gs);
        float e[8];
        { float a[8]; const float* Wg = Wr + (4 + gi * 8) * DM;
#pragma unroll
          for (int n = 0; n < 8; ++n) { a[n] = 0.f;
#pragma unroll
              for (int j = 0; j < 4; ++j) { const f32x4 w = *(const f32x4*)(Wg + n * DM + 256 * j + 4 * F.lane); a[n] += (v[j].x * w.x + v[j].y * w.y) + (v[j].z * w.z + v[j].w * w.w); } }
          { const bool up = (F.lane & 32) != 0;
#pragma unroll
            for (int i = 0; i < 4; ++i) { const float snd = up ? a[i] : a[i + 4]; const float rcv = __shfl_xor(snd, 32); a[i] = (up ? a[i + 4] : a[i]) + rcv; } }
          { const bool up = (F.lane & 16) != 0;
#pragma unroll
            for (int i = 0; i < 2; ++i) { const float snd = up ? a[i] : a[i + 2]; const float rcv = __shfl_xor(snd, 16); a[i] = (up ? a[i + 2] : a[i]) + rcv; } }
          { const bool up = (F.lane & 8) != 0; const float snd = up ? a[0] : a[1]; const float rcv = __shfl_xor(snd, 8); a[0] = (up ? a[1] : a[0]) + rcv; }
#pragma unroll
          for (int o = 4; o >= 1; o >>= 1) a[0] += __shfl_xor(a[0], o);
#pragma unroll
          for (int n = 0; n < 8; ++n) e[n] = __shfl(a[0], n * 8) + be[gi * 8 + n]; }
        int i1 = 0; float v1 = e[0];
#pragma unroll
        for (int n = 1; n < 8; ++n) if (e[n] > v1) { v1 = e[n]; i1 = n; }
        int i2 = -1; float v2 = -INFINITY;
#pragma unroll
        for (int n = 0; n < 8; ++n) if (n != i1 && e[n] > v2) { v2 = e[n]; i2 = n; }
        if (i2 < 0) { i2 = (i1 == 0) ? 1 : 0; v2 = e[i1 == 0 ? 1 : 0]; }
        const float p2 = __expf(v2 - v1); const float ga = gwt * __builtin_amdgcn_rcpf(1.f + p2), gb = ga * p2;
        if (!DRY && F.lane == 0) {
            const int e1 = gi * 8 + i1, e2 = gi * 8 + i2;
            int* rc = rec + (F.wave * 18 + kk) * 4;
            rc[0] = e1; rc[1] = e2; rc[2] = atomicAdd(&lcnt[e1], 1); rc[3] = atomicAdd(&lcnt[e2], 1);
            EXPID[row * 2] = e1; EXPID[row * 2 + 1] = e2; GATEV[row * 2] = ga; GATEV[row * 2 + 1] = gb;
        }
    }
    if (!DRY) {
        __syncthreads();
        if (F.tid < 32) { const int c = lcnt[F.tid]; lcnt[F.tid] = (c > 0) ? (int)atomicAdd(&CNT[F.tid * CNT_STRIDE], (unsigned)c) : 0; }
        __syncthreads();
        if (F.lane == 0) { int k2 = 0;
            for (int row = gw; row < nrows; row += NGW, ++k2) { const int* rc = rec + (F.wave * 18 + k2) * 4;
                LIST[(size_t)rc[0] * MTOT + lcnt[rc[0]] + rc[2]] = row * 2; LIST[(size_t)rc[1] * MTOT + lcnt[rc[1]] + rc[3]] = row * 2 + 1; } }
    }
}

__device__ __forceinline__ void moe_offsets(const unsigned* CNT, int (&cnt)[32], int (&poff)[33]) {
    int acc = 0;
#pragma unroll
    for (int e = 0; e < 32; ++e) { cnt[e] = (int)__hip_atomic_load(CNT + e * CNT_STRIDE, __ATOMIC_RELAXED, __HIP_MEMORY_SCOPE_AGENT); poff[e] = acc; acc += ((cnt[e] + 255) >> 8) << 8; }
    poff[32] = acc;
}
__device__ __forceinline__ void ph_moe_up_naive(Frame& F, int l) {
    const bf16* HB = WSP(bf16, WS_HB); const bf16* UPT = WSP(bf16, WS_UPT); bf16* HBUF = WSP(bf16, WS_HBUF); const int* LIST = WSP(int, WS_LIST);
    const unsigned* CNT = WSP(unsigned, WS_CTL) + CW_CNT + l * 32 * CNT_STRIDE;
    int* tab = (int*)(F.lds + 64 * 1024);
    if (F.tid == 0) { int cnt[32], poff[33]; moe_offsets(CNT, cnt, poff);
#pragma unroll
        for (int e = 0; e < 32; ++e) { tab[e] = cnt[e]; tab[32 + e] = poff[e]; } tab[64] = poff[32]; }
    __syncthreads();
    const int ntile128 = tab[64] / 128;
    for (int it = F.bid; it < ntile128 * 8; it += F.G) {
        const int mt = it >> 3, nt = it & 7, pos0 = mt * 128;
        int e = 0;
        for (int q = 1; q < 32; ++q) if (pos0 >= tab[32 + q]) e = q;
        const int i0 = pos0 - tab[32 + e], cnt = tab[e];
        if (i0 >= cnt) continue;
        const int n0 = nt * 64;
        const bf16* W = UPT + (size_t)e * 1024 * 1024 + (size_t)((n0 >> 7) * 256 + (n0 & 127)) * DM;
        const bf16* const Bt[2] = { W, W + (size_t)128 * DM };
        const int* lst = LIST + (size_t)e * MTOT;
        ngemm_tile<2>(F, HB, DM, Bt, DM, DM, [&](int i) { return (i0 + i < cnt) ? (long)(lst[i0 + i] >> 1) : -1L; },
            [&](float (&acc)[2][4][4], int r0, int c0) {
#pragma unroll
                for (int i = 0; i < 4; ++i)
#pragma unroll
                    for (int j = 0; j < 4; ++j) HBUF[(size_t)(pos0 + r0 + i) * FF + n0 + c0 + j] = f2bf(siluf(acc[0][i][j]) * acc[1][i][j]);
            });
    }
}
__device__ __forceinline__ void ph_moe_dn_naive(Frame& F, int l) {
    const bf16* DNT = WSP(bf16, WS_DNT); const bf16* HBUF = WSP(bf16, WS_HBUF); const int* LIST = WSP(int, WS_LIST); const float* GATEV = WSP(float, WS_GATEV); bf16* FB = WSP(bf16, WS_F);
    const unsigned* CNT = WSP(unsigned, WS_CTL) + CW_CNT + l * 32 * CNT_STRIDE;
    int* tab = (int*)(F.lds + 64 * 1024);
    if (F.tid == 0) { int cnt[32], poff[33]; moe_offsets(CNT, cnt, poff);
#pragma unroll
        for (int e = 0; e < 32; ++e) { tab[e] = cnt[e]; tab[32 + e] = poff[e]; } tab[64] = poff[32]; }
    __syncthreads();
    const int ntile128 = tab[64] / 128;
    for (int it = F.bid; it < ntile128 * 16; it += F.G) {
        const int mt = it >> 4, nt = it & 15, pos0 = mt * 128;
        int e = 0;
        for (int q = 1; q < 32; ++q) if (pos0 >= tab[32 + q]) e = q;
        const int i0 = pos0 - tab[32 + e], cnt = tab[e];
        if (i0 >= cnt) continue;
        const int n0 = nt * 64;
        const bf16* const Bt[1] = { DNT + (size_t)e * 1024 * 512 + (size_t)n0 * FF };
        const int* lst = LIST + (size_t)e * MTOT;
        ngemm_tile<1>(F, HBUF, FF, Bt, FF, FF, [&](int i) { return (i0 + i < cnt) ? (long)(pos0 + i) : -1L; },
            [&](float (&acc)[1][4][4], int r0, int c0) {
#pragma unroll
                for (int i = 0; i < 4; ++i) { if (i0 + r0 + i < cnt) { const int ent = lst[i0 + r0 + i]; const int row = ent >> 1, k = ent & 1; const float gt = GATEV[ent];
#pragma unroll
                    for (int j = 0; j < 4; ++j) FB[((size_t)k * MTOT + row) * DM + n0 + c0 + j] = f2bf(gt * acc[0][i][j]); } }
            });
    }
}

namespace pg8 {
#define PG8_LAS __attribute__((address_space(3)))
typedef short bf16x8 __attribute__((ext_vector_type(8)));
constexpr int BM = 256, BK = 64, HALF = 128, HTB = HALF * BK * 2, STAGE_BYTES = 8 * HTB, NXCD = 8, WGM = 8;
__host__ __device__ __forceinline__ int lds_byte(int r, int c) { const int st = (r >> 4) * 2 + (c >> 5), rr = r & 15, cc = c & 31, ob = rr * 64 + cc * 2; return st * 1024 + (ob ^ (((ob >> 9) & 1) << 5)); }
__host__ __device__ __forceinline__ void stage_rc(int b, int& R, int& C) { const int st = b / 1024, sb = b % 1024, swz = sb ^ (((sb >> 9) & 1) << 5); R = (st >> 1) * 16 + swz / 64; C = (st & 1) * 32 + (swz % 64) / 2; }
__host__ __device__ __forceinline__ int perm32(int rho) { const int n = rho >> 4, i = rho & 15; return 8 * (i >> 2) + 4 * n + (i & 3); }
struct Unit { int pm, pn; size_t aoff, boff; int e, i0, cnt; };
struct StaticOrder {
    int nM, nN, nwg, G, c; size_t tstep;
    __device__ void init(int M, int N, int K, int G_, int c_) { nM = M / BM; nN = N / BM; nwg = nM * nN; G = G_; c = c_; tstep = (size_t)BM * K * 2; }
    __device__ bool next(int i, Unit& u) const {
        const long L = (long)i * G + c; if (L >= nwg) return false;
        int wgid = (int)L; { const int q = nwg / NXCD, r = nwg % NXCD, xcd = wgid % NXCD, off = wgid / NXCD; wgid = (xcd < r ? xcd * (q + 1) : r * (q + 1) + (xcd - r) * q) + off; }
        const int nig = WGM * nN, gid = wgid / nig, fm = gid * WGM, gsz = (nM - fm) < WGM ? (nM - fm) : WGM;
        u.pm = fm + ((wgid % nig) % gsz); u.pn = (wgid % nig) / gsz; u.aoff = (size_t)u.pm * tstep; u.boff = (size_t)u.pn * tstep; u.e = 0; u.i0 = 0; u.cnt = 0; return true;
    }
    __device__ unsigned gather_off(const Unit&, int) const { return 0u; }
};
template <bool GATH>
struct MoeOrder {
    const int* tab; const int* list; int npn, G, c, ntiles; size_t bstride_e; unsigned K2;
    __device__ bool next(int i, Unit& u) const {
        int mt, pn;
        if ((G & 7) == 0 && npn == 4) { const int x = c & 7, jj = c >> 3, per = G >> 3; const long uu = (long)i * per + jj; mt = (int)(uu >> 2) * 8 + x; pn = (int)(uu & 3); if (mt >= ntiles) return false; }
        else { const long L = (long)i * G + c; if (L >= (long)ntiles * npn) return false; mt = (int)(L / npn); pn = (int)(L % npn); }
        const int pos0 = mt * 256; int e = 0;
#pragma unroll
        for (int st = 16; st >= 1; st >>= 1) { const int pq = __builtin_amdgcn_readfirstlane(tab[32 + e + st]); if (pos0 >= pq) e += st; }
        u.pm = mt; u.pn = pn; u.e = e; u.i0 = pos0 - __builtin_amdgcn_readfirstlane(tab[32 + e]); u.cnt = __builtin_amdgcn_readfirstlane(tab[e]);
        u.aoff = GATH ? (size_t)0 : (size_t)pos0 * K2; u.boff = (size_t)e * bstride_e + (size_t)pn * 256 * K2; return true;
    }
    __device__ unsigned gather_off(const Unit& u, int r) const { const int idx = u.i0 + r; const int row = (idx < u.cnt) ? (list[(size_t)u.e * MTOT + idx] >> 1) : 0; return (unsigned)row * K2; }
};
__device__ __forceinline__ unsigned cvt_pk_bf16(float lo, float hi) { unsigned r; asm volatile("v_cvt_pk_bf16_f32 %0, %1, %2" : "=v"(r) : "v"(lo), "v"(hi)); return r; }

template <class Epi, class Sched, bool GATHER>
__device__ __forceinline__ void gemm_phase(PG8_LAS unsigned char* lds, const char* Abase, const char* Bbase, int K, const Sched& S, const Epi& E) {
    const int tid = threadIdx.x, wid = __builtin_amdgcn_readfirstlane(tid >> 6), lane = tid & 63, wr = wid >> 2, wc = wid & 3, fr = lane & 15, fq = lane >> 4;
    const int nt = K / BK;
    unsigned voffA[2], voffB[2]; int RA[2];
#pragma unroll
    for (int i = 0; i < 2; ++i) { int R, C; stage_rc(tid * 16 + i * 8192, R, C); const int Rb = Epi::PERM ? ((R & ~31) + perm32(R & 31)) : R;
        RA[i] = R; voffA[i] = GATHER ? (unsigned)(C * 2) : (unsigned)(R * K + C) * 2u; voffB[i] = (unsigned)(Rb * K + C) * 2u; }
    const size_t kstep = (size_t)(BK * 2);
    const size_t hstep = (size_t)HALF * K * 2;
    const size_t hstepA = GATHER ? (size_t)0 : hstep;
    const unsigned ldsw = (unsigned)wid * 1024u;
    const int aoff = lds_byte(wr * 64 + fr, fq * 8), boff = lds_byte(wc * 32 + fr, fq * 8);
    unsigned gC[2][2], gN[2][2];
#define PG8_SA(b, h) (((b) * 2 + (h)) * HTB)
#define PG8_SB(b, h) ((4 + (b) * 2 + (h)) * HTB)
#define PG8_STAGE(bufoff, gbase, voff) do { _Pragma("unroll") for (int _i = 0; _i < 2; ++_i) \
        __builtin_amdgcn_global_load_lds((const unsigned*)((const char*)(gbase) + (voff)[_i]), (PG8_LAS unsigned*)(lds + (bufoff) + ldsw + _i * 8192), 16, 0, 0); } while (0)
#define PG8_STAGE_A(bufoff, gbase, h, NX) do { if constexpr (GATHER) { _Pragma("unroll") for (int _i = 0; _i < 2; ++_i) \
        __builtin_amdgcn_global_load_lds((const unsigned*)((const char*)(gbase) + ((NX) ? gN[h][_i] : gC[h][_i])), (PG8_LAS unsigned*)(lds + (bufoff) + ldsw + _i * 8192), 16, 0, 0); } \
        else { PG8_STAGE(bufoff, (const char*)(gbase) + (h) * hstepA, voffA); } } while (0)
#define PG8_LDA(dst, b, h) do { _Pragma("unroll") for (int m = 0; m < 4; ++m) _Pragma("unroll") for (int k = 0; k < 2; ++k) dst[m][k] = *(const PG8_LAS bf16x8*)(lds + PG8_SA(b, h) + aoff + m * 2048 + k * 1024); } while (0)
#define PG8_LDB(dst, b, h) do { _Pragma("unroll") for (int n = 0; n < 2; ++n) _Pragma("unroll") for (int k = 0; k < 2; ++k) dst[n][k] = *(const PG8_LAS bf16x8*)(lds + PG8_SB(b, h) + boff + n * 2048 + k * 1024); } while (0)
#define PG8_MMA(ai, bj, At, Bt) do { __builtin_amdgcn_s_setprio(1); _Pragma("unroll") for (int m = 0; m < 4; ++m) _Pragma("unroll") for (int n = 0; n < 2; ++n) _Pragma("unroll") for (int k = 0; k < 2; ++k) \
        acc[ai][bj][m][n] = __builtin_amdgcn_mfma_f32_16x16x32_bf16(Bt[n][k], At[m][k], acc[ai][bj][m][n], 0, 0, 0); __builtin_amdgcn_s_setprio(0); } while (0)
#define PG8_WAIT_V(n) asm volatile("s_waitcnt vmcnt(" #n ")" ::: "memory")
#define PG8_WAIT_L(n) asm volatile("s_waitcnt lgkmcnt(" #n ")" ::: "memory")
#define PG8_BAR __builtin_amdgcn_s_barrier()
#define PG8_SCHED __builtin_amdgcn_sched_barrier(0)
    Unit cur, nxt; int ui = 0;
    if (!S.next(0, cur)) return;
    f32x4 acc[2][2][4][2];
#pragma unroll
    for (int a = 0; a < 2; ++a)
#pragma unroll
        for (int b = 0; b < 2; ++b)
#pragma unroll
            for (int m = 0; m < 4; ++m)
#pragma unroll
                for (int n = 0; n < 2; ++n) acc[a][b][m][n] = (f32x4){0.f, 0.f, 0.f, 0.f};
    bf16x8 At[4][2], B0[2][2], B1[2][2];
    const char* cA = Abase + cur.aoff; const char* cB = Bbase + cur.boff;
    if constexpr (GATHER) {
#pragma unroll
        for (int h = 0; h < 2; ++h)
#pragma unroll
            for (int i = 0; i < 2; ++i) { gC[h][i] = S.gather_off(cur, h * HALF + RA[i]) + voffA[i]; gN[h][i] = gC[h][i]; }
    }
    PG8_STAGE(PG8_SB(0, 0), cB, voffB); PG8_STAGE(PG8_SB(0, 1), cB + hstep, voffB); PG8_STAGE_A(PG8_SA(0, 0), cA, 0, false); PG8_STAGE_A(PG8_SA(0, 1), cA, 1, false);
    if (wr == 1) PG8_BAR;
    PG8_WAIT_V(2); PG8_BAR;
    PG8_STAGE(PG8_SB(1, 0), cB + kstep, voffB); PG8_STAGE_A(PG8_SA(1, 0), cA + kstep, 0, false); PG8_STAGE(PG8_SB(1, 1), cB + hstep + kstep, voffB);
    PG8_WAIT_V(6); PG8_BAR;
    for (;;) {
        const bool has_next = S.next(ui + 1, nxt);
        const char* nA = has_next ? Abase + nxt.aoff : cA; const char* nB = has_next ? Bbase + nxt.boff : cB;
        if constexpr (GATHER) { if (has_next) {
#pragma unroll
            for (int h = 0; h < 2; ++h)
#pragma unroll
                for (int i = 0; i < 2; ++i) gN[h][i] = S.gather_off(nxt, h * HALF + RA[i]) + voffA[i]; } }
        for (int t = 0; t < nt; t += 2) {
            const bool last = (t == nt - 2);
            const char* a1 = cA + (size_t)(t + 1) * kstep;
            const char* a2 = last ? nA : cA + (size_t)(t + 2) * kstep; const char* b2 = last ? nB : cB + (size_t)(t + 2) * kstep;
            const char* a3 = a2 + kstep; const char* b3 = b2 + kstep;
            PG8_LDB(B0, 0, 0); PG8_LDB(B1, 0, 1); PG8_SCHED; PG8_LDA(At, 0, 0); PG8_STAGE_A(PG8_SA(1, 1), a1, 1, false);
            PG8_WAIT_V(8); PG8_WAIT_L(0); PG8_BAR; PG8_MMA(0, 0, At, B0); PG8_MMA(0, 1, At, B1); PG8_BAR; PG8_SCHED;
            PG8_LDA(At, 0, 1); PG8_STAGE(PG8_SB(0, 0), b2, voffB); PG8_STAGE(PG8_SB(0, 1), b2 + hstep, voffB); PG8_STAGE_A(PG8_SA(0, 0), a2, 0, last);
            PG8_WAIT_V(8); PG8_WAIT_L(0); PG8_BAR; PG8_MMA(1, 0, At, B0); PG8_MMA(1, 1, At, B1); PG8_BAR; PG8_SCHED;
            PG8_LDB(B0, 1, 0); PG8_LDB(B1, 1, 1); PG8_SCHED; PG8_LDA(At, 1, 0); PG8_STAGE_A(PG8_SA(0, 1), a2, 1, last);
            PG8_WAIT_V(8); PG8_WAIT_L(0); PG8_BAR; PG8_MMA(0, 0, At, B0); PG8_MMA(0, 1, At, B1); PG8_BAR; PG8_SCHED;
            PG8_LDA(At, 1, 1); PG8_STAGE(PG8_SB(1, 0), b3, voffB); PG8_STAGE(PG8_SB(1, 1), b3 + hstep, voffB); PG8_STAGE_A(PG8_SA(1, 0), a3, 0, last);
            PG8_WAIT_V(8); PG8_WAIT_L(0); PG8_BAR; PG8_MMA(1, 0, At, B0); PG8_MMA(1, 1, At, B1); PG8_BAR; PG8_SCHED;
        }
        if (wr == 0) PG8_BAR;
        E(acc, cur, wr, wc, fr, fq);
        if (!has_next) break;
#pragma unroll
        for (int a = 0; a < 2; ++a)
#pragma unroll
            for (int b = 0; b < 2; ++b)
#pragma unroll
                for (int m = 0; m < 4; ++m)
#pragma unroll
                    for (int n = 0; n < 2; ++n) acc[a][b][m][n] = (f32x4){0.f, 0.f, 0.f, 0.f};
        cur = nxt; cA = nA; cB = nB; ++ui;
        if constexpr (GATHER) {
#pragma unroll
            for (int h = 0; h < 2; ++h)
#pragma unroll
                for (int i = 0; i < 2; ++i) gC[h][i] = gN[h][i]; }
        if (wr == 1) PG8_BAR;
    }
    PG8_WAIT_V(0);
    PG8_BAR;
#undef PG8_SA
#undef PG8_SB
#undef PG8_STAGE
#undef PG8_STAGE_A
#undef PG8_LDA
#undef PG8_LDB
#undef PG8_MMA
#undef PG8_WAIT_V
#undef PG8_WAIT_L
#undef PG8_BAR
#undef PG8_SCHED
}
struct EpiWin { static constexpr bool PERM = true; bf16* U; float* GT; const float* bias; const float* rc; const float* rs;
    __device__ __forceinline__ void operator()(const f32x4 (&acc)[2][2][4][2], const Unit& u, int wr, int wc, int fr, int fq) const {
        const int row0 = u.pm * BM + wr * 64 + fr;
        if (u.pn < 13) {
            const int col0 = u.pn * BM + wc * 32 + 8 * fq;
            f32x4 bv[2][2];
#pragma unroll
            for (int bj = 0; bj < 2; ++bj)
#pragma unroll
                for (int n = 0; n < 2; ++n) bv[bj][n] = *(const f32x4*)(bias + col0 + bj * HALF + 4 * n);
            const bool rope_ = (u.pn >= 7 && u.pn <= 10);
#pragma unroll
            for (int ai = 0; ai < 2; ++ai) {
                f32x4 c4v[4], s4v[4];
                if (rope_) {
#pragma unroll
                    for (int m = 0; m < 4; ++m) { const int row = row0 + ai * HALF + m * 16; const int ti = ((row < NLAT) ? (row & 4095) : 0) * 32 + (wc & 1) * 16 + 4 * fq; c4v[m] = *(const f32x4*)(rc + ti); s4v[m] = *(const f32x4*)(rs + ti); }
                }
#pragma unroll
                for (int m = 0; m < 4; ++m) { bf16* rowp = U + (size_t)(row0 + ai * HALF + m * 16) * UW + col0;
#pragma unroll
                    for (int bj = 0; bj < 2; ++bj) { f32x4 v0 = acc[ai][bj][m][0] + bv[bj][0], v1 = acc[ai][bj][m][1] + bv[bj][1];
                        if (rope_) {
                            const int row = row0 + ai * HALF + m * 16; const float sc = (u.pn <= 8) ? QSCALE : 1.f;
                            if (row < NLAT) { const f32x4 c4 = c4v[m], s4 = s4v[m];
                                const f32x4 a0 = v0, a1 = v1;
                                v0[0] = (a0[0] * c4[0] - a0[1] * s4[0]) * sc; v0[1] = (a0[1] * c4[0] + a0[0] * s4[0]) * sc; v0[2] = (a0[2] * c4[1] - a0[3] * s4[1]) * sc; v0[3] = (a0[3] * c4[1] + a0[2] * s4[1]) * sc;
                                v1[0] = (a1[0] * c4[2] - a1[1] * s4[2]) * sc; v1[1] = (a1[1] * c4[2] + a1[0] * s4[2]) * sc; v1[2] = (a1[2] * c4[3] - a1[3] * s4[3]) * sc; v1[3] = (a1[3] * c4[3] + a1[2] * s4[3]) * sc; }
                            else { v0 = v0 * sc; v1 = v1 * sc; } }
                        u32x4 w; w.x = cvt_pk_bf16(v0[0], v0[1]); w.y = cvt_pk_bf16(v0[2], v0[3]); w.z = cvt_pk_bf16(v1[0], v1[1]); w.w = cvt_pk_bf16(v1[2], v1[3]);
                        *(u32x4*)(rowp + bj * HALF) = w; } } }
        } else if (wc == 0 && fq < 2) {
            const f32x4 b0 = *(const f32x4*)(bias + UW + 8 * fq), b1 = *(const f32x4*)(bias + UW + 8 * fq + 4);
#pragma unroll
            for (int ai = 0; ai < 2; ++ai)
#pragma unroll
                for (int m = 0; m < 4; ++m) { float* g = GT + (size_t)(row0 + ai * HALF + m * 16) * 16 + 8 * fq;
                    *(f32x4*)g = acc[ai][0][m][0] + b0; *(f32x4*)(g + 4) = acc[ai][0][m][1] + b1; }
        }
    }
};
struct EpiWout { static constexpr bool PERM = false; float* out; unsigned char* ws; const float* mods_l;
    __device__ __forceinline__ void operator()(const f32x4 (&acc)[2][2][4][2], const Unit& u, int wr, int wc, int fr, int fq) const {
        const int rt = u.pm * BM; const int bsel = rt < NLAT ? (rt >> 12) : 8;
        const float* g1 = mods_l + (size_t)bsel * 6144 + 2 * DM;
        const int r0 = rt + wr * 64 + fr, col0 = u.pn * BM + wc * 32 + 4 * fq;
        f32x4 gv[2][2];
#pragma unroll
        for (int bj = 0; bj < 2; ++bj)
#pragma unroll
            for (int n = 0; n < 2; ++n) gv[bj][n] = *(const f32x4*)(g1 + col0 + bj * HALF + n * 16);
#pragma unroll
        for (int ai = 0; ai < 2; ++ai) {
            u32x2 xv[4][2][2];
#pragma unroll
            for (int m = 0; m < 4; ++m) { const bf16* rowp = xrow_ptr(out, ws, r0 + ai * HALF + m * 16) + col0;
#pragma unroll
                for (int bj = 0; bj < 2; ++bj)
#pragma unroll
                    for (int n = 0; n < 2; ++n) xv[m][bj][n] = *(const u32x2*)(rowp + bj * HALF + n * 16); }
#pragma unroll
            for (int m = 0; m < 4; ++m) { bf16* rowp = xrow_ptr(out, ws, r0 + ai * HALF + m * 16) + col0;
#pragma unroll
                for (int bj = 0; bj < 2; ++bj)
#pragma unroll
                    for (int n = 0; n < 2; ++n) { const u32x2 x1 = xv[m][bj][n]; const f32x4 y = gv[bj][n] * acc[ai][bj][m][n];
                        u32x2 xo; xo.x = cvt_pk_bf16(__uint_as_float(x1.x << 16) + y[0], __uint_as_float(x1.x & 0xffff0000u) + y[1]); xo.y = cvt_pk_bf16(__uint_as_float(x1.y << 16) + y[2], __uint_as_float(x1.y & 0xffff0000u) + y[3]);
                        *(u32x2*)(rowp + bj * HALF + n * 16) = xo; } } }
    }
};
struct EpiMoeUp { static constexpr bool PERM = true; bf16* HBUF;
    __device__ __forceinline__ void operator()(const f32x4 (&acc)[2][2][4][2], const Unit& u, int wr, int wc, int fr, int fq) const {
        const int row0 = u.pm * BM + wr * 64 + fr, col0 = u.pn * HALF + wc * 32 + 8 * fq;
#pragma unroll
        for (int ai = 0; ai < 2; ++ai)
#pragma unroll
            for (int m = 0; m < 4; ++m) { float h[8];
#pragma unroll
                for (int n = 0; n < 2; ++n)
#pragma unroll
                    for (int j = 0; j < 4; ++j) { const float a = acc[ai][0][m][n][j], b = acc[ai][1][m][n][j]; h[n * 4 + j] = a * __builtin_amdgcn_rcpf(1.f + __expf(-a)) * b; }
                u32x4 w; w.x = cvt_pk_bf16(h[0], h[1]); w.y = cvt_pk_bf16(h[2], h[3]); w.z = cvt_pk_bf16(h[4], h[5]); w.w = cvt_pk_bf16(h[6], h[7]);
                *(u32x4*)(HBUF + (size_t)(row0 + ai * HALF + m * 16) * FF + col0) = w; }
    }
};
struct EpiMoeDn { static constexpr bool PERM = true; bf16* FB; const int* list; const float* gatev;
    __device__ __forceinline__ void operator()(const f32x4 (&acc)[2][2][4][2], const Unit& u, int wr, int wc, int fr, int fq) const {
        const int col0 = u.pn * BM + wc * 32 + 8 * fq; const int* lst = list + (size_t)u.e * MTOT;
        int ent[2][4]; float g[2][4];
#pragma unroll
        for (int ai = 0; ai < 2; ++ai)
#pragma unroll
            for (int m = 0; m < 4; ++m) { const int idx = u.i0 + ai * HALF + wr * 64 + m * 16 + fr; ent[ai][m] = (idx < u.cnt) ? lst[idx] : -1; }
#pragma unroll
        for (int ai = 0; ai < 2; ++ai)
#pragma unroll
            for (int m = 0; m < 4; ++m) g[ai][m] = (ent[ai][m] >= 0) ? gatev[ent[ai][m]] : 0.f;
#pragma unroll
        for (int ai = 0; ai < 2; ++ai)
#pragma unroll
            for (int m = 0; m < 4; ++m) {
                if (ent[ai][m] >= 0) { const int en = ent[ai][m]; const float gg = g[ai][m]; bf16* rowp = FB + ((size_t)(en & 1) * MTOT + (en >> 1)) * DM + col0;
#pragma unroll
                    for (int bj = 0; bj < 2; ++bj) { const f32x4 v0 = acc[ai][bj][m][0] * gg, v1 = acc[ai][bj][m][1] * gg;
                        u32x4 w; w.x = cvt_pk_bf16(v0[0], v0[1]); w.y = cvt_pk_bf16(v0[2], v0[3]); w.z = cvt_pk_bf16(v1[0], v1[1]); w.w = cvt_pk_bf16(v1[2], v1[3]);
                        *(u32x4*)(rowp + bj * HALF) = w; } } }
    }
};
}

__device__ __forceinline__ void ph_win_fast(Frame& F, int l) {
    pg8::StaticOrder S; S.init(MTOT, UW, DM, F.G, F.bid);
    pg8::EpiWin E{WSP(bf16, WS_U), WSP(float, WS_GATES), WSP(float, WS_BINR) + l * NPADW, WSP(float, WS_ROPE), WSP(float, WS_ROPE) + 4096 * 32};
    pg8::gemm_phase<pg8::EpiWin, pg8::StaticOrder, false>((PG8_LAS unsigned char*)F.lds, (const char*)WSP(bf16, WS_HB), (const char*)(WSP(bf16, WS_WIN) + (size_t)l * NPADW * DM), DM, S, E);
}
__device__ __forceinline__ void ph_gates(Frame& F, int l) {
    typedef short bf16x8g __attribute__((ext_vector_type(8))); typedef float f32x16g __attribute__((ext_vector_type(16)));
    const bf16* HB = WSP(bf16, WS_HB); const bf16* W = WSP(bf16, WS_WIN) + (size_t)l * NPADW * DM + (size_t)UW * DM; const float* bias = WSP(float, WS_BINR) + l * NPADW + UW; float* GT = WSP(float, WS_GATES);
    const int gw = F.bid * NWAVES + F.wave, NGW = F.G * NWAVES, r32 = F.lane & 31, hi = F.lane >> 5;
    for (int it = F.wave * F.G + F.bid; it < MTOT / 32; it += NGW) {
        const bf16* ap = HB + (size_t)(it * 32 + r32) * DM + 8 * hi; const bf16* bp = W + (size_t)r32 * DM + 8 * hi;
        f32x16g acc = f32x16g{};
#pragma unroll 1
        for (int kb = 0; kb < 64; kb += 16) { bf16x8g av[16], bv[16];
#pragma unroll
            for (int ks = 0; ks < 16; ++ks) { av[ks] = *(const bf16x8g*)(ap + 16 * (kb + ks)); bv[ks] = *(const bf16x8g*)(bp + 16 * (kb + ks)); }
            __builtin_amdgcn_sched_barrier(0);
#pragma unroll
            for (int ks = 0; ks < 16; ++ks) acc = __builtin_amdgcn_mfma_f32_32x32x16_bf16(av[ks], bv[ks], acc, 0, 0, 0);
            __builtin_amdgcn_sched_barrier(0); }
        if (r32 < 16) { const float bv = bias[r32];
#pragma unroll
            for (int r = 0; r < 16; ++r) GT[(size_t)(it * 32 + (r & 3) + 8 * (r >> 2) + 4 * hi) * 16 + r32] = acc[r] + bv; }
    }
}
__device__ __forceinline__ void ph_wout_fast(Frame& F, int l) {
    pg8::StaticOrder S; S.init((l == 1) ? NLAT : MTOT, DM, DM, F.G, F.bid);
    pg8::EpiWout E{F.p->out, F.ws, WSP(float, WS_MODS) + (size_t)l * 9 * 6144};
    pg8::gemm_phase<pg8::EpiWout, pg8::StaticOrder, false>((PG8_LAS unsigned char*)F.lds, (const char*)WSP(bf16, WS_HB), (const char*)(WSP(bf16, WS_WOUT) + (size_t)l * DM * DM), DM, S, E);
}
__device__ __forceinline__ void moe_tab(Frame& F, int l, int* tab) {
    const unsigned* CNT = WSP(unsigned, WS_CTL) + CW_CNT + l * 32 * CNT_STRIDE;
    if (F.tid < 32) tab[F.tid] = (int)__hip_atomic_load(CNT + F.tid * CNT_STRIDE, __ATOMIC_RELAXED, __HIP_MEMORY_SCOPE_AGENT);
    __syncthreads();
    if (F.tid == 0) { int acc = 0;
#pragma unroll 1
        for (int e = 0; e < 32; ++e) { const int c = tab[e]; tab[32 + e] = acc; acc += ((c + 255) >> 8) << 8; }
        tab[64] = acc; }
    __syncthreads();
}
__device__ __forceinline__ void ph_moe_up_fast(Frame& F, int l) {
    int* tab = (int*)(F.lds + 136 * 1024); moe_tab(F, l, tab);
    pg8::MoeOrder<true> S{tab, WSP(int, WS_LIST), 4, F.G, F.bid, __builtin_amdgcn_readfirstlane(tab[64]) / 256, (size_t)1024 * 1024 * 2, (unsigned)(DM * 2)};
    pg8::EpiMoeUp E{WSP(bf16, WS_HBUF)};
    pg8::gemm_phase<pg8::EpiMoeUp, pg8::MoeOrder<true>, true>((PG8_LAS unsigned char*)F.lds, (const char*)WSP(bf16, WS_HB), (const char*)WSP(bf16, WS_UPT), DM, S, E);
}
__device__ __forceinline__ void ph_moe_dn_fast(Frame& F, int l) {
    int* tab = (int*)(F.lds + 136 * 1024); moe_tab(F, l, tab);
    pg8::MoeOrder<false> S{tab, WSP(int, WS_LIST), 4, F.G, F.bid, __builtin_amdgcn_readfirstlane(tab[64]) / 256, (size_t)1024 * 512 * 2, (unsigned)(FF * 2)};
    pg8::EpiMoeDn E{WSP(bf16, WS_F), WSP(int, WS_LIST), WSP(float, WS_GATEV)};
    pg8::gemm_phase<pg8::EpiMoeDn, pg8::MoeOrder<false>, false>((PG8_LAS unsigned char*)F.lds, (const char*)WSP(bf16, WS_HBUF), (const char*)WSP(bf16, WS_DNT), FF, S, E);
}


#ifndef FAST_GEMM
#define FAST_GEMM 1
#endif
#ifndef FAST_MOE
#define FAST_MOE 1
#endif
constexpr int NPH = 20;
__global__ void __launch_bounds__(NTHREADS, 2) mega(Params prm) {
    extern __shared__ __attribute__((aligned(16))) unsigned char lds[];
    const int g_wave0 = __builtin_amdgcn_readfirstlane(threadIdx.x >> 6);
#define mkframe(L) mkframe_(L, g_wave0)
    Frame F = mkframe(lds);
    volatile LAS unsigned* st = (volatile LAS unsigned*)(LAS unsigned char*)(lds + LDS_CTL_OFF);
    if (F.tid < 64) st[F.tid] = 0u;
    __syncthreads();
    const int lo = prm.ph_lo, hi = prm.ph_hi;
    const bool multi = (hi - lo) > 1;
    XcdBarrier bar; bar.bar = WSP(unsigned, WS_CTL) + CW_BAR; bar.x = 0; bar.st = st;
    if (multi) bar = xcd_barrier_post(WSP(unsigned, WS_CTL) + CW_BAR, st);
#ifndef PHMASK
#define PHMASK 0xFFFFF
#endif
#define IN(k) (((PHMASK >> (((k) == 0) ? 0 : ((k) == 19) ? 10 : (((k) - 1) % 9 + 1))) & 1) && lo <= (k) && (k) < hi)
#define SEAM(k) do { if (IN(k) && IN((k) + 1)) xcd_barrier(bar); } while (0)
    if (IN(0)) { F = mkframe(lds); for (int rep = 0; rep < DUP(8); ++rep) { ph_prologue(F); __syncthreads(); } ph_prologue_b(F); } SEAM(0);
#define LAYER_BODY(l) { constexpr int pb = 1 + 9 * (l);\
        if (IN(pb + 0)) { F = mkframe(lds); ph_norm1<false>(F, l); if (l == 0 && DUP(9) == 2) ph_norm1<false>(F, l); if (l == 1 && !DYN_MIX) conv_moe_weights(F, 1); } SEAM(pb + 0);\
        if (IN(pb + 1)) { F = mkframe(lds); ph_win_fast(F, l); __syncthreads(); ph_gates(F, l); if (DUP(3) == 2) { __syncthreads(); F = mkframe(lds); ph_win_fast(F, l); } } SEAM(pb + 1);\
        if (IN(pb + 2)) { F = mkframe(lds); ph_postu(F, l); __syncthreads(); ph_taps(F, l); if (DUP(11) == 2) { __syncthreads(); ph_postu(F, l); } if (FAST_MLSTM) { for (int rep = 0; rep < DUP(4); ++rep) { __syncthreads(); ph_ml_s1(F, l); } } } SEAM(pb + 2);\
        if (IN(pb + 3)) { F = mkframe(lds); if (DYN_MIX) ph_mixers_dyn(F, l, lds); else ph_mixers_naive(F, l); } SEAM(pb + 3);\
        if (IN(pb + 4)) { F = mkframe(lds); for (int rep = 0; rep < DUP(5); ++rep) { ph_assemble(F, l); __syncthreads(); } } SEAM(pb + 4);\
        if (IN(pb + 5)) { F = mkframe(lds); if (FAST_GEMM) ph_wout_fast(F, l); else ph_wout_naive(F, l); } SEAM(pb + 5);\
        if (IN(pb + 6)) { F = mkframe(lds); ph_norm2_router<false>(F, l); if (DUP(10) == 2) { __syncthreads(); ph_norm2_router<true>(F, l); } } SEAM(pb + 6);\
        if (IN(pb + 7)) { F = mkframe(lds); ph_moe_up_fast(F, l); if (DUP(6) == 2) { __syncthreads(); F = mkframe(lds); ph_moe_up_fast(F, l); } } SEAM(pb + 7);\
        if (IN(pb + 8)) { F = mkframe(lds); ph_moe_dn_fast(F, l); if (DUP(7) == 2) { __syncthreads(); F = mkframe(lds); ph_moe_dn_fast(F, l); } } SEAM(pb + 8);\
    }
    LAYER_BODY(0)
    LAYER_BODY(1)
#undef LAYER_BODY
    if (IN(19)) { F = mkframe(lds); ph_norm1<true>(F, 2); }
#undef IN
#undef SEAM
}

#ifndef MK_ONE_LAUNCH
#define MK_ONE_LAUNCH 1
#endif
extern "C" void kernel_launch(void* const* d_in, const int* in_sizes, int n_in, void* d_out, int out_size, void* d_ws, size_t ws_size, hipStream_t stream) {
    static int grid = 0;
    if (grid == 0) {
        if (n_in != 34 || out_size != NLAT * DM || ws_size < WS_END) { fprintf(stderr, "kernel_launch: unexpected problem (n_in %d out %d ws %zu)\n", n_in, out_size, ws_size); grid = -1; return; }
        int dev = 0, cus = 0;
        if (hipGetDevice(&dev) != hipSuccess || hipDeviceGetAttribute(&cus, hipDeviceAttributeMultiprocessorCount, dev) != hipSuccess) { grid = -1; return; }
        if (hipFuncSetAttribute((const void*)mega, hipFuncAttributeMaxDynamicSharedMemorySize, LDS_BYTES) != hipSuccess) { fprintf(stderr, "kernel_launch: hipFuncSetAttribute failed\n"); grid = -1; return; }
        int per_cu = 0;
        if (hipOccupancyMaxActiveBlocksPerMultiprocessor(&per_cu, (const void*)mega, NTHREADS, LDS_BYTES) != hipSuccess || per_cu < 1) { fprintf(stderr, "kernel_launch: occupancy query says %d\n", per_cu); }
        (void)hipGetLastError();
        grid = cus;
    }
    if (grid < 0) return;
    (void)hipMemsetAsync((char*)d_ws + WS_CTL, 0, CTL_BYTES, stream);
    Params p{};
    for (int i = 0; i < 34; ++i) p.in[i] = (const float*)d_in[i];
    p.out = (float*)d_out; p.ws = (unsigned char*)d_ws;
#if MK_ONE_LAUNCH
    p.ph_lo = 0; p.ph_hi = NPH;
    hipLaunchKernelGGL(mega, dim3(grid), dim3(NTHREADS), LDS_BYTES, stream, p);
#else
    for (int k = 0; k < NPH; ++k) { p.ph_lo = k; p.ph_hi = k + 1; hipLaunchKernelGGL(mega, dim3(grid), dim3(NTHREADS), LDS_BYTES, stream, p); }
#endif
}
```

```cpp
#include <hip/hip_runtime.h>
#include <cstdio>
#include <cstdint>
#ifndef FAST_ATTN
#define FAST_ATTN 1
#endif
#ifndef FAST_HYENA
#define FAST_HYENA 1
#endif
#ifndef FAST_MLSTM
#define FAST_MLSTM 1
#endif
#ifndef DYN_MIX
#define DYN_MIX 1
#endif
#ifndef DUPMASK
#define DUPMASK 0
#endif
#define DUP(x) (1 + (((DUPMASK) >> (x)) & 1))

constexpr int DM = 1024, NB = 8, SEQ = 4096, CTXL = 256;
constexpr int NLAT = NB * SEQ;
constexpr int NCTX = NB * CTXL;
constexpr int MTOT = NLAT + NCTX;
constexpr int NIN = 3344;
constexpr int UW = 3328;
constexpr int NPADW = 3584;
constexpr int U_HY = 0, U_MLQ = 768, U_MLK = 1024, U_MLV = 1280, U_MLO = 1536, U_DAQ = 1792, U_DAK = 2304, U_DAV = 2816;
constexpr int NEXP = 32, FF = 512;
constexpr float EPS = 1e-6f;
constexpr float QSCALE = 0.125f * 1.4426950408889634f;

typedef unsigned short bf16;
typedef float f32x4 __attribute__((ext_vector_type(4)));
typedef unsigned u32x4 __attribute__((ext_vector_type(4)));
typedef unsigned u32x2 __attribute__((ext_vector_type(2)));

constexpr size_t MiB = 1u << 20;
constexpr size_t WS_CTL = 0, CTL_BYTES = 1 * MiB;
constexpr size_t WS_MODS = 1 * MiB;
constexpr size_t WS_ROPE = 2 * MiB;
constexpr size_t WS_H2L = 3 * MiB;
constexpr size_t WS_H2C = 5 * MiB;
constexpr size_t WS_LAM = 5 * MiB + 65536;
constexpr size_t WS_BINR = 5 * MiB + 131072;
constexpr size_t WS_WIN = 6 * MiB;
constexpr size_t WS_WOUT = 21 * MiB;
constexpr size_t WS_UPT = 25 * MiB;
constexpr size_t WS_DNT = 89 * MiB;
constexpr size_t WS_XC = 121 * MiB;
constexpr size_t WS_GATES = 129 * MiB;
constexpr size_t WS_EXPID = 132 * MiB;
constexpr size_t WS_GATEV = 132 * MiB + 512 * 1024;
constexpr size_t WS_LIST = 133 * MiB;
constexpr size_t WS_HB = 138 * MiB;
constexpr size_t WS_HYV = 206 * MiB, WS_HYX1 = 222 * MiB, WS_HYX2 = 238 * MiB, WS_HYY = 254 * MiB;
constexpr size_t WS_HYVC = 270 * MiB, WS_HYX1C = 271 * MiB, WS_HYX2C = 272 * MiB, WS_HYYC = 273 * MiB;
constexpr size_t WS_MLQ = 274 * MiB, WS_MLK = 291 * MiB;
constexpr size_t WS_MLH = 308 * MiB;
constexpr size_t WS_U = 342 * MiB;
constexpr size_t WS_HBUF = WS_U;
constexpr size_t WS_F = WS_U + 76 * MiB;
constexpr size_t WS_CST = WS_MLH;
constexpr size_t WS_NST = 563 * MiB;
constexpr size_t WS_MLOC = 563 * MiB + 1280 * 1024;
constexpr size_t WS_MENT = 563 * MiB + 1536 * 1024;
constexpr size_t WS_TAPS = 566 * MiB;
constexpr size_t WS_END = 582 * MiB;
constexpr int HBUF_ROWS = 77824;

constexpr int CW_BAR = 4096;
constexpr int CW_CNT = 40960;
constexpr int CNT_STRIDE = 64;
constexpr int CW_Q = 9216;

constexpr int NTHREADS = 512, NWAVES = 8;
constexpr int LDS_BYTES = 163840;
constexpr int LDS_CTL_OFF = 160 * 1024 - 256;

struct Params { const float* in[34]; float* out; unsigned char* ws; int ph_lo, ph_hi; };

enum { I_X = 0, I_C, I_CTX, I_CCTX, I_ADAW, I_ADAB, I_N1W, I_N2W, I_WIN, I_BIN, I_WOUT, I_HCW, I_HCB, I_FW1, I_FB1, I_FW2, I_FB2, I_FW3, I_FB3, I_FREQ, I_HBD,
       I_MCW, I_MCB, I_MNW, I_LAMBDA, I_SUBLN, I_WG, I_BG, I_WE, I_BE, I_W1, I_W3, I_W2, I_FNW };

__device__ __forceinline__ float bf2f(bf16 v) { return __uint_as_float(((unsigned)v) << 16); }
__device__ __forceinline__ bf16 f2bf(float f) { unsigned u = __float_as_uint(f); return (bf16)((u + 0x7fffu + ((u >> 16) & 1u)) >> 16); }
typedef float f32x2_t __attribute__((ext_vector_type(2))); typedef __bf16 bf16x2_t __attribute__((ext_vector_type(2)));
__device__ __forceinline__ unsigned cvtpk(float lo, float hi) { f32x2_t v = {lo, hi}; bf16x2_t b = __builtin_convertvector(v, bf16x2_t); return __builtin_bit_cast(unsigned, b); }
__device__ __forceinline__ unsigned pk2(float lo, float hi) { return cvtpk(lo, hi); }
__device__ __forceinline__ float wave_sum(float v) {
#pragma unroll
    for (int o = 1; o < 64; o <<= 1) v += __shfl_xor(v, o);
    return v;
}
__device__ __forceinline__ float siluf(float x) { return x * __builtin_amdgcn_rcpf(1.f + __expf(-x)); }
__device__ __forceinline__ float sigmoidf(float x) { return __builtin_amdgcn_rcpf(1.f + __expf(-x)); }
__device__ __forceinline__ float logsigmoidf(float x) { return fminf(x, 0.f) - log1pf(__expf(-fabsf(x))); }

#define LAS __attribute__((address_space(3)))
#define XB_TMO      128
#define XB_XCNT(j)  (256  + 64 * (j))
#define XB_XSUB(j)  (1280 + 64 * (j))
#define XB_XGEN(j)  (2304 + 64 * (j))
#define XB_TOP      3328
#define XB_TOPGEN   3392
#define XCD_BAR_WORDS 3456
#define XB_SPIN_CAP (1u << 24)
__device__ __forceinline__ unsigned xb_ld(unsigned* p)              { return __hip_atomic_load(p, __ATOMIC_RELAXED, __HIP_MEMORY_SCOPE_AGENT); }
__device__ __forceinline__ unsigned xb_add(unsigned* p, unsigned v) { return __hip_atomic_fetch_add(p, v, __ATOMIC_RELAXED, __HIP_MEMORY_SCOPE_AGENT); }
__device__ __forceinline__ unsigned xb_xcc_id() { return (unsigned)__builtin_amdgcn_s_getreg((3 << 11) | 20) & 0xFu; }
#define XB_SPIN(cond, bar) do { unsigned _sp = 0; while (cond) { __builtin_amdgcn_s_sleep(1); \
    if ((++_sp & 255u) == 0u) { if (xb_ld(&(bar)[XB_TMO])) break; if (_sp > XB_SPIN_CAP) { atomicAdd(&(bar)[XB_TMO], 1u); break; } } } } while (0)
struct XcdBarrier { unsigned* bar; unsigned x; volatile LAS unsigned* st; };
__device__ __forceinline__ XcdBarrier xcd_barrier_post(unsigned* bar, volatile LAS unsigned* st) {
    XcdBarrier b; b.bar = bar; b.x = xb_xcc_id(); b.st = st;
    if (threadIdx.x == 0) (void)xb_add(&bar[XB_XCNT(b.x)], 1u);
    return b;
}
__device__ __forceinline__ void xcd_barrier_complete(unsigned* bar, unsigned x, unsigned& nloc, unsigned& nx) {
    const unsigned G = gridDim.x * gridDim.y * gridDim.z;
    unsigned sum, cnt, mine, sp = 0u;
    for (;;) {
        sum = 0u; cnt = 0u; mine = 0u;
#pragma unroll
        for (unsigned j = 0; j < 16; ++j) { const unsigned c = xb_ld(&bar[XB_XCNT(j)]); sum += c; cnt += (c > 0u) ? 1u : 0u; mine = (j == x) ? c : mine; }
        if (sum == G) break;
        __builtin_amdgcn_s_sleep(1);
        if ((++sp & 255u) == 0u) { if (xb_ld(&bar[XB_TMO])) break; if (sp > XB_SPIN_CAP) { atomicAdd(&bar[XB_TMO], 1u); break; } }
    }
    nloc = mine > 0u ? mine : 1u; nx = cnt > 0u ? cnt : 1u;
}
__device__ __forceinline__ void xcd_barrier(const XcdBarrier& b) {
    asm volatile("s_waitcnt vmcnt(0)" ::: "memory");
    __syncthreads();
    if (threadIdx.x == 0) {
        unsigned* bar = b.bar;
        __builtin_amdgcn_s_waitcnt(0);
        unsigned nloc = b.st[0], nx = b.st[1];
        if (nloc == 0u) { xcd_barrier_complete(bar, b.x, nloc, nx); b.st[0] = nloc; b.st[1] = nx; }
        const unsigned old = xb_add(&bar[XB_XSUB(b.x)], 1u);
        const unsigned gen = old / nloc;
        if (old + 1u == (gen + 1u) * nloc) {
            __builtin_amdgcn_fence(__ATOMIC_RELEASE, "agent");
            asm volatile("s_waitcnt vmcnt(0)" ::: "memory");
            const unsigned og = xb_add(&bar[XB_TOP], 1u);
            const unsigned tg = og / nx;
            if (og + 1u == (tg + 1u) * nx) xb_add(&bar[XB_TOPGEN], 1u);
            else XB_SPIN(xb_ld(&bar[XB_TOPGEN]) == tg, bar);
            __builtin_amdgcn_fence(__ATOMIC_ACQUIRE, "agent");
            xb_add(&bar[XB_XGEN(b.x)], 1u);
            asm volatile("s_waitcnt vmcnt(0)" ::: "memory");
        } else {
            XB_SPIN(xb_ld(&bar[XB_XGEN(b.x)]) == gen, bar);
            __builtin_amdgcn_fence(__ATOMIC_ACQUIRE, "agent");
            asm volatile("s_waitcnt vmcnt(0)" ::: "memory");
        }
    }
    __syncthreads();
}

#define CAS __attribute__((address_space(4)))
struct Frame {
    unsigned char* lds; const CAS Params* p; unsigned char* ws;
    int tid, lane, wave, G, bid;
};
#define WSP(T, off) ((T*)(F.ws + (off)))
__device__ __forceinline__ Frame mkframe_(unsigned char* lds, int g_wave) {
    Frame F; F.lds = lds;
    unsigned long long pv = (unsigned long long)__builtin_amdgcn_kernarg_segment_ptr(); asm volatile("" : "+s"(pv));
    F.p = (const CAS Params*)pv; F.ws = F.p->ws;
    int tid = threadIdx.x; asm volatile("" : "+v"(tid)); F.tid = tid; F.lane = tid & 63; F.wave = __builtin_amdgcn_readfirstlane(tid >> 6);
    int g = gridDim.x, b = blockIdx.x; asm volatile("" : "+s"(g), "+s"(b)); F.G = g; F.bid = b;
    return F;
}

__device__ __forceinline__ void tr_item(const float* W, int ldw, int k0, int cs, int nvalid, bf16* WT, int ldt, int rd, float* scr, int lane, bool rperm = false) {
    { const int kr = lane >> 3, c4 = (lane & 7) * 4;
      f32x4 v[8];
#pragma unroll
      for (int i = 0; i < 8; ++i) v[i] = *(const f32x4*)(W + (size_t)(k0 + 8 * i + kr) * ldw + cs + c4);
#pragma unroll
      for (int i = 0; i < 8; ++i) { float* d = scr + (8 * i + kr) * 33;
#pragma unroll
          for (int q = 0; q < 4; ++q) { const int sc_ = c4 + q; const int n = rperm ? ((sc_ < 16) ? 2 * sc_ : 2 * (sc_ - 16) + 1) : sc_;
              d[n] = (sc_ < nvalid) ? v[i][q] : 0.f; } } }
    asm volatile("s_waitcnt lgkmcnt(0)" ::: "memory");
    const int c = lane & 7;
#pragma unroll
    for (int j = 0; j < 4; ++j) { const int n = (lane >> 3) + 8 * j; const float* s = scr + (8 * c) * 33 + n;
        u32x4 o; o.x = pk2(s[0 * 33], s[1 * 33]); o.y = pk2(s[2 * 33], s[3 * 33]); o.z = pk2(s[4 * 33], s[5 * 33]); o.w = pk2(s[6 * 33], s[7 * 33]);
        *(u32x4*)(WT + (size_t)(rd + n) * ldt + k0 + 8 * c) = o; }
    asm volatile("s_waitcnt lgkmcnt(0)" ::: "memory");
}
__device__ __forceinline__ void conv_moe_weights(Frame& F, int l) {
    float* scr = (float*)(F.lds) + F.wave * (64 * 33);
    const int gw = F.bid * NWAVES + F.wave, NGW = F.G * NWAVES;
    const float* w1 = F.p->in[I_W1] + (size_t)l * NEXP * DM * FF;
    const float* w3 = F.p->in[I_W3] + (size_t)l * NEXP * DM * FF;
    const float* w2 = F.p->in[I_W2] + (size_t)l * NEXP * FF * DM;
    bf16* UPT = WSP(bf16, WS_UPT); bf16* DNT = WSP(bf16, WS_DNT);
    for (int it = gw; it < 3 * 8192; it += NGW) {
        const int which = it / 8192, r = it % 8192, e = r / 256, q = r % 256;
        if (which < 2) { const int kb = q / 16, nb = q % 16, n0 = nb * 32, rd = (n0 >> 7) * 256 + (n0 & 127) + which * 128;
            tr_item((which ? w3 : w1) + (size_t)e * DM * FF, FF, kb * 64, n0, 32, UPT + (size_t)e * 1024 * 1024, 1024, rd, scr, F.lane); }
        else { const int kb = q / 32, nb = q % 32;
            tr_item(w2 + (size_t)e * FF * DM, DM, kb * 64, nb * 32, 32, DNT + (size_t)e * 1024 * 512, 512, nb * 32, scr, F.lane); }
    }
}
__device__ __forceinline__ void ph_prologue(Frame& F) {
    const CAS Params& P = *F.p;
    float* mods = WSP(float, WS_MODS);
    if (F.bid < 192) {
        float* act = (float*)F.lds;
        float* red = act + 9 * 1024;
        for (int i = F.tid; i < 9 * 1024; i += NTHREADS) act[i] = siluf(i < 8192 ? P.in[I_C][i] : P.in[I_CCTX][i - 8192]);
        __syncthreads();
        for (int it = F.bid; it < 192; it += F.G) {
            const int l = it / 96, nb = it % 96, n = nb * 64 + F.lane;
            const float* W = P.in[I_ADAW] + (size_t)l * DM * 6144;
            float acc[9];
#pragma unroll
            for (int r = 0; r < 9; ++r) acc[r] = 0.f;
#pragma unroll 16
            for (int k = F.wave * 128; k < F.wave * 128 + 128; ++k) {
                const float w = W[(size_t)k * 6144 + n];
#pragma unroll
                for (int r = 0; r < 9; ++r) acc[r] += act[r * 1024 + k] * w;
            }
#pragma unroll
            for (int r = 0; r < 9; ++r) red[(F.wave * 9 + r) * 64 + F.lane] = acc[r];
            __syncthreads();
            for (int o = F.tid; o < 576; o += NTHREADS) { const int r = o / 64, cl = o % 64; float s2 = 0.f;
                for (int w = 0; w < 8; ++w) s2 += red[(w * 9 + r) * 64 + cl];
                mods[(size_t)(l * 9 + r) * 6144 + nb * 64 + cl] = s2 + P.in[I_ADAB][l * 6144 + nb * 64 + cl]; }
            __syncthreads();
        }
    }
    __syncthreads();
}
__device__ __forceinline__ void ph_prologue_b(Frame& F) {
    const CAS Params& P = *F.p;
    const int gw = F.bid * NWAVES + F.wave, NGW = F.G * NWAVES;
    const int gt = F.bid * NTHREADS + F.tid, NGT = F.G * NTHREADS;
    {
        float* scr = (float*)(F.lds) + F.wave * (64 * 33);
        bf16* WIN = WSP(bf16, WS_WIN); bf16* WOUT = WSP(bf16, WS_WOUT);
        for (int base_ = 0; base_ < 2 * 16 * 105 + 2 * 16 * 32; base_ += NGW) { const int it = (base_ + NGW > 2 * 16 * 105 + 2 * 16 * 32) ? base_ + (NGW - 1 - gw) : base_ + gw; if (it >= 2 * 16 * 105 + 2 * 16 * 32) break;
            if (it < 3360) { const int l = it / 1680, r = it % 1680, kb = r / 105, nbk = r % 105;
                int cs, rd, nv = 32;
                if (nbk < 56) { cs = 32 * nbk; rd = 32 * nbk; } else if (nbk < 104) { cs = 1808 + 32 * (nbk - 56); rd = 32 * nbk; } else { cs = 1792; rd = 3328; nv = 16; }
                tr_item(P.in[I_WIN] + (size_t)l * DM * NIN, NIN, kb * 64, cs, nv, WIN + (size_t)l * NPADW * DM, DM, rd, scr, F.lane, nbk >= 56 && nbk < 88);
            } else { const int r0 = it - 3360, l = r0 / 512, r = r0 % 512, kb = r / 32, nb = r % 32;
                tr_item(P.in[I_WOUT] + (size_t)l * DM * DM, DM, kb * 64, nb * 32, 32, WOUT + (size_t)l * DM * DM, DM, nb * 32, scr, F.lane); }
        }
        for (int i = gt; i < 2 * 224 * (DM / 8); i += NGT) { const int l = i / (224 * 128), r = i % (224 * 128);
            *(u32x4*)(WIN + (size_t)l * NPADW * DM + (size_t)(3360 + r / 128) * DM + (r % 128) * 8) = (u32x4){0u, 0u, 0u, 0u}; }
    }
    if (!DYN_MIX) conv_moe_weights(F, 0);
    { float* rc = WSP(float, WS_ROPE); float* rs = rc + 4096 * 32;
      for (int i = gt; i < 4096 * 32; i += NGT) { const int t = i >> 5, k = i & 31; const float pos = (k < 16) ? (float)(t >> 6) : (float)(t & 63);
          const float inv = powf(10000.f, -(float)(2 * (k & 15)) / 32.f); const float ang = pos * inv; rc[i] = cosf(ang); rs[i] = sinf(ang); } }
    { float* H2L = WSP(float, WS_H2L); float* H2C = WSP(float, WS_H2C);
      for (int base_ = 0; base_ < 2 * 4096 + 256; base_ += NGW) { const int it = (base_ + NGW > 2 * 4096 + 256) ? base_ + (NGW - 1 - gw) : base_ + gw; if (it >= 2 * 4096 + 256) break;
          int l, t, L; float* dst;
          if (it < 8192) { l = it >> 12; t = it & 4095; L = 4096; dst = H2L + ((size_t)l * 4096 + t) * 64; } else { l = 0; t = it - 8192; L = 256; dst = H2C + (size_t)t * 64; }
          const float tn = (float)t / (float)(L - 1);
          const float w = (6.283185307179586f / (float)L) * (float)t;
          const int j = F.lane;
          float zk = 0.f;
          if (j == 0) zk = tn;
          else if (j <= 16) { const float f = 1e-4f + (float)(j - 1) * ((15.f - 1e-4f) / 15.f); zk = cosf(f * w); }
          else if (j <= 32) { const float f = 1e-4f + (float)(j - 17) * ((15.f - 1e-4f) / 15.f); zk = -sinf(f * w); }
          const float* w1 = P.in[I_FW1] + (size_t)l * 33 * 64; const float* w2 = P.in[I_FW2] + (size_t)l * 64 * 64;
          const float fr = P.in[I_FREQ][l * 64 + j];
          float a = P.in[I_FB1][l * 64 + j];
#pragma unroll
          for (int k = 0; k < 33; ++k) a += __shfl(zk, k) * w1[k * 64 + j];
          const float h1 = sinf(fr * a);
          float b = P.in[I_FB2][l * 64 + j];
#pragma unroll
          for (int k = 0; k < 64; ++k) b += __shfl(h1, k) * w2[k * 64 + j];
          dst[j] = sinf(fr * b);
      } }
    if (F.bid == 0 && F.wave == 0) {
        for (int l = 0; l < 2; ++l) { const float* lp = P.in[I_LAMBDA] + l * 256;
            const float s1 = wave_sum(lp[F.lane] * lp[64 + F.lane]), s2 = wave_sum(lp[128 + F.lane] * lp[192 + F.lane]);
            if (F.lane == 0) WSP(float, WS_LAM)[l] = expf(s1) - expf(s2) + (0.8f - 0.6f * expf(-0.3f * (float)l)); }
    }
    { float* BR = WSP(float, WS_BINR);
      for (int i = gt; i < 2 * NPADW; i += NGT) { const int l = i / NPADW, n = i % NPADW; float v = 0.f;
          if (n < 1792) v = P.in[I_BIN][l * NIN + n]; else if (n < 2816) { const int q = n & 31; v = P.in[I_BIN][l * NIN + (n & ~31) + 16 + (q >> 1) + 16 * (q & 1)]; } else if (n < 3328) v = P.in[I_BIN][l * NIN + n + 16]; else if (n < 3344) v = P.in[I_BIN][l * NIN + 1792 + (n - 3328)];
          BR[i] = v; } }
}

__device__ __forceinline__ bf16* xrow_ptr(float* out, unsigned char* ws, int row) { return row < NLAT ? (bf16*)out + (size_t)row * 2048 + 1024 : (bf16*)(ws + WS_XC) + (size_t)(row - NLAT) * DM; }
template <bool FIN>
__device__ __forceinline__ void ph_norm1(Frame& F, int l) {
    const CAS Params& P = *F.p;
    const int gw = F.bid * NWAVES + F.wave, NGW = F.G * NWAVES;
    const float* mods = WSP(float, WS_MODS);
    bf16* HB = WSP(bf16, WS_HB); const bf16* FB = WSP(bf16, WS_F);
    const int nrows = FIN ? NLAT : MTOT;
    f32x4 nv[4]; u32x2 nx[4], na[4], nb[4];
#define N1_LOAD(R) do { const int r_ = (R); \
        if (l == 0) { const float* src_ = r_ < NLAT ? P.in[I_X] + (size_t)r_ * DM : P.in[I_CTX] + (size_t)(r_ - NLAT) * DM; \
            _Pragma("unroll") for (int j = 0; j < 4; ++j) nv[j] = *(const f32x4*)(src_ + 256 * j + 4 * F.lane); } \
        else { const bf16* xb_ = xrow_ptr(P.out, F.ws, r_); \
            _Pragma("unroll") for (int j = 0; j < 4; ++j) { const int c_ = 256 * j + 4 * F.lane; nx[j] = *(const u32x2*)(xb_ + c_); na[j] = *(const u32x2*)(FB + (size_t)r_ * DM + c_); nb[j] = *(const u32x2*)(FB + (size_t)(MTOT + r_) * DM + c_); } } } while (0)
    if (gw < nrows) N1_LOAD(gw);
    f32x4 wv[4];
    { const float* wsrc = FIN ? P.in[I_FNW] : P.in[I_N1W] + l * DM;
#pragma unroll
      for (int j = 0; j < 4; ++j) wv[j] = *(const f32x4*)(wsrc + 256 * j + 4 * F.lane); }
    for (int row = gw; row < nrows; row += NGW) {
        const int bsel = row < NLAT ? (row >> 12) : 8;
        bf16* Xb = xrow_ptr(P.out, F.ws, row);
        f32x4 v[4]; u32x2 cx[4], ca[4], cb2[4];
#pragma unroll
        for (int j = 0; j < 4; ++j) { v[j] = nv[j]; cx[j] = nx[j]; ca[j] = na[j]; cb2[j] = nb[j]; }
        if (row + NGW < nrows) N1_LOAD(row + NGW);
        f32x4 s1v[4], s0v[4];
        if (!FIN) { const float* sh_ = mods + (size_t)(l * 9 + bsel) * 6144; const float* sc_ = sh_ + DM;
#pragma unroll
            for (int j = 0; j < 4; ++j) { s1v[j] = *(const f32x4*)(sc_ + 256 * j + 4 * F.lane); s0v[j] = *(const f32x4*)(sh_ + 256 * j + 4 * F.lane); } }
        if (l != 0) { const float* g2 = mods + (size_t)((l - 1) * 9 + bsel) * 6144 + 5 * DM;
#pragma unroll
            for (int j = 0; j < 4; ++j) { const int c = 256 * j + 4 * F.lane; const u32x2 xv = cx[j]; const f32x4 g = *(const f32x4*)(g2 + c);
                const u32x2 a = ca[j], b = cb2[j];
                v[j].x = __uint_as_float(xv.x << 16) + g.x * (__uint_as_float(a.x << 16) + __uint_as_float(b.x << 16)); v[j].y = __uint_as_float(xv.x & 0xffff0000u) + g.y * (__uint_as_float(a.x & 0xffff0000u) + __uint_as_float(b.x & 0xffff0000u));
                v[j].z = __uint_as_float(xv.y << 16) + g.z * (__uint_as_float(a.y << 16) + __uint_as_float(b.y << 16)); v[j].w = __uint_as_float(xv.y & 0xffff0000u) + g.w * (__uint_as_float(a.y & 0xffff0000u) + __uint_as_float(b.y & 0xffff0000u)); } }
        float ss = 0.f;
#pragma unroll
        for (int j = 0; j < 4; ++j) ss += (v[j].x * v[j].x + v[j].y * v[j].y) + (v[j].z * v[j].z + v[j].w * v[j].w);
        const float rstd = rsqrtf(wave_sum(ss) * (1.f / DM) + EPS);
        if (FIN) {
            float* Orow = P.out + (size_t)row * DM;
#pragma unroll
            for (int j = 0; j < 4; ++j) { const int c = 256 * j + 4 * F.lane; const f32x4 w = wv[j];
                *(f32x4*)(Orow + c) = v[j] * rstd * w; }
        } else {
#pragma unroll
            for (int j = 0; j < 4; ++j) { const int c = 256 * j + 4 * F.lane; u32x2 xo; xo.x = pk2(v[j].x, v[j].y); xo.y = pk2(v[j].z, v[j].w); *(u32x2*)(Xb + c) = xo;
                const f32x4 w = wv[j], s1 = s1v[j], s0 = s0v[j];
                const f32x4 h = v[j] * rstd * w * (s1 + 1.f) + s0;
                u32x2 o; o.x = pk2(h.x, h.y); o.y = pk2(h.z, h.w); *(u32x2*)(HB + (size_t)row * DM + c) = o; }
        }
    }
}

#undef N1_LOAD
template <int NBM, class AR, class EP>
__device__ __forceinline__ void ngemm_tile(Frame& F, const bf16* A, int lda, const bf16* const (&Bt)[NBM], int ldb, int K, AR arow, EP epi) {
    float* As = (float*)F.lds;
    float* Bs = As + 32 * 132;
    const int ty = F.tid >> 4, tx = F.tid & 15;
    float acc[NBM][4][4];
#pragma unroll
    for (int q = 0; q < NBM; ++q)
#pragma unroll
        for (int i = 0; i < 4; ++i)
#pragma unroll
            for (int j = 0; j < 4; ++j) acc[q][i][j] = 0.f;
    const int lr = F.tid >> 2, lk = (F.tid & 3) * 8;
    const long ar = arow(lr);
    for (int k0 = 0; k0 < K; k0 += 32) {
        { u32x4 v = (u32x4){0u, 0u, 0u, 0u}; if (ar >= 0) v = *(const u32x4*)(A + (size_t)ar * lda + k0 + lk);
          As[(lk + 0) * 132 + lr] = __uint_as_float(v.x << 16); As[(lk + 1) * 132 + lr] = __uint_as_float(v.x & 0xffff0000u);
          As[(lk + 2) * 132 + lr] = __uint_as_float(v.y << 16); As[(lk + 3) * 132 + lr] = __uint_as_float(v.y & 0xffff0000u);
          As[(lk + 4) * 132 + lr] = __uint_as_float(v.z << 16); As[(lk + 5) * 132 + lr] = __uint_as_float(v.z & 0xffff0000u);
          As[(lk + 6) * 132 + lr] = __uint_as_float(v.w << 16); As[(lk + 7) * 132 + lr] = __uint_as_float(v.w & 0xffff0000u); }
        if (F.tid < 256) {
#pragma unroll
            for (int q = 0; q < NBM; ++q) { const u32x4 v = *(const u32x4*)(Bt[q] + (size_t)lr * ldb + k0 + lk); float* bs = Bs + q * 32 * 68;
              bs[(lk + 0) * 68 + lr] = __uint_as_float(v.x << 16); bs[(lk + 1) * 68 + lr] = __uint_as_float(v.x & 0xffff0000u);
              bs[(lk + 2) * 68 + lr] = __uint_as_float(v.y << 16); bs[(lk + 3) * 68 + lr] = __uint_as_float(v.y & 0xffff0000u);
              bs[(lk + 4) * 68 + lr] = __uint_as_float(v.z << 16); bs[(lk + 5) * 68 + lr] = __uint_as_float(v.z & 0xffff0000u);
              bs[(lk + 6) * 68 + lr] = __uint_as_float(v.w << 16); bs[(lk + 7) * 68 + lr] = __uint_as_float(v.w & 0xffff0000u); }
        }
        __syncthreads();
#pragma unroll 4
        for (int kk = 0; kk < 32; ++kk) {
            const f32x4 a = *(const f32x4*)(As + kk * 132 + ty * 4);
#pragma unroll
            for (int q = 0; q < NBM; ++q) { const f32x4 b = *(const f32x4*)(Bs + q * 32 * 68 + kk * 68 + tx * 4);
#pragma unroll
                for (int i = 0; i < 4; ++i) { acc[q][i][0] += a[i] * b[0]; acc[q][i][1] += a[i] * b[1]; acc[q][i][2] += a[i] * b[2]; acc[q][i][3] += a[i] * b[3]; } }
        }
        __syncthreads();
    }
    epi(acc, ty * 4, tx * 4);
}

__device__ __forceinline__ void ph_win_naive(Frame& F, int l) {
    const bf16* HB = WSP(bf16, WS_HB); const bf16* W = WSP(bf16, WS_WIN) + (size_t)l * NPADW * DM; const float* bias = WSP(float, WS_BINR) + l * NPADW;
    bf16* U = WSP(bf16, WS_U); float* GT = WSP(float, WS_GATES);
    const int nmt = MTOT / 128, nnt = 53;
    for (int it = F.bid; it < nmt * nnt; it += F.G) {
        const int mt = it / nnt, nt = it % nnt, m0 = mt * 128, n0 = nt * 64;
        const bf16* const Bt[1] = { W + (size_t)n0 * DM };
        ngemm_tile<1>(F, HB, DM, Bt, DM, DM, [&](int i) { return (long)(m0 + i); },
            [&](float (&acc)[1][4][4], int r0, int c0) {
#pragma unroll
                for (int i = 0; i < 4; ++i)
#pragma unroll
                    for (int j = 0; j < 4; ++j) { const int row = m0 + r0 + i, col = n0 + c0 + j; const float v = acc[0][i][j] + bias[col];
                        if (col < UW) U[(size_t)row * UW + col] = f2bf(v); else if (col < UW + 16) GT[(size_t)row * 16 + col - UW] = v; }
            });
    }
}
__device__ __forceinline__ void ph_wout_naive(Frame& F, int l) {
    const CAS Params& P = *F.p;
    const bf16* MIX = WSP(bf16, WS_HB); const bf16* W = WSP(bf16, WS_WOUT) + (size_t)l * DM * DM; const float* mods = WSP(float, WS_MODS); float* XC = WSP(float, WS_XC);
    const int M = (l == 1) ? NLAT : MTOT; const int nmt = M / 128, nnt = 16;
    for (int it = F.bid; it < nmt * nnt; it += F.G) {
        const int mt = it / nnt, nt = it % nnt, m0 = mt * 128, n0 = nt * 64;
        const bf16* const Bt[1] = { W + (size_t)n0 * DM };
        ngemm_tile<1>(F, MIX, DM, Bt, DM, DM, [&](int i) { return (long)(m0 + i); },
            [&](float (&acc)[1][4][4], int r0, int c0) {
#pragma unroll
                for (int i = 0; i < 4; ++i) { const int row = m0 + r0 + i; const int bsel = row < NLAT ? (row >> 12) : 8;
                    float* Xrow = row < NLAT ? P.out + (size_t)row * DM : XC + (size_t)(row - NLAT) * DM; const float* g1 = mods + (size_t)(l * 9 + bsel) * 6144 + 2 * DM;
#pragma unroll
                    for (int j = 0; j < 4; ++j) { const int col = n0 + c0 + j; Xrow[col] += g1[col] * acc[0][i][j]; } }
            });
    }
}

#define PU_UNPK(v, f) do { f[0] = __uint_as_float(v.x << 16); f[1] = __uint_as_float(v.x & 0xffff0000u); f[2] = __uint_as_float(v.y << 16); f[3] = __uint_as_float(v.y & 0xffff0000u); \
        f[4] = __uint_as_float(v.z << 16); f[5] = __uint_as_float(v.z & 0xffff0000u); f[6] = __uint_as_float(v.w << 16); f[7] = __uint_as_float(v.w & 0xffff0000u); } while (0)
__device__ __forceinline__ void ph_postu(Frame& F, int l) {
    const CAS Params& P = *F.p;
    const bf16* U = WSP(bf16, WS_U);
    {
        const float* cw = P.in[I_HCW] + (size_t)l * 3 * 768; const float* cb = P.in[I_HCB] + (size_t)l * 768;
        const int gw = F.bid * NWAVES + F.wave, NGW = F.G * NWAVES;
        bf16* T = (bf16*)(F.lds + F.wave * 9216);
        const int nrowblk = (l == 0) ? MTOT / 64 : NLAT / 64;
        for (int it = gw; it < nrowblk * 12; it += NGW) {
            const int rb = it / 12, cbk = it % 12, row0 = rb * 64, c0 = cbk * 64;
            const bool lat = row0 < NLAT; const int t0 = lat ? (row0 & 4095) : ((row0 - NLAT) & 255); const int Ls = lat ? SEQ : CTXL; const int seq = lat ? (row0 >> 12) : ((row0 - NLAT) >> 8);
            asm volatile("s_waitcnt lgkmcnt(0)" ::: "memory");
#pragma unroll
            for (int q = 0; q < 9; ++q) { const int i = q * 64 + F.lane; if (i < 66 * 8) { const int rr = i >> 3, ch = i & 7; const int t = t0 - 1 + rr;
                u32x4 v = (u32x4){0u, 0u, 0u, 0u}; if (t >= 0 && t < Ls) v = *(const u32x4*)(U + (size_t)(row0 - 1 + rr) * UW + U_HY + c0 + ch * 8);
                *(u32x2*)(T + rr * 68 + ch * 8) = (u32x2){v.x, v.y}; *(u32x2*)(T + rr * 68 + ch * 8 + 4) = (u32x2){v.z, v.w}; } }
            asm volatile("s_waitcnt lgkmcnt(0)" ::: "memory");
            const int j = c0 + F.lane; const float w0 = cw[j], w1 = cw[768 + j], w2 = cw[1536 + j], bb = cb[j];
            const int which = j >> 8, chn = j & 255;
            bf16* dst = (lat ? WSP(bf16, which == 0 ? WS_HYV : which == 1 ? WS_HYX1 : WS_HYX2) : WSP(bf16, which == 0 ? WS_HYVC : which == 1 ? WS_HYX1C : WS_HYX2C)) + ((size_t)chn * 8 + seq) * Ls + t0;
            float xm = bf2f(T[F.lane]), x0 = bf2f(T[68 + F.lane]);
#pragma unroll
            for (int g = 0; g < 8; ++g) { float o[8];
#pragma unroll
                for (int q = 0; q < 8; ++q) { const float xp = bf2f(T[(g * 8 + q + 2) * 68 + F.lane]); o[q] = w0 * xm + w1 * x0 + w2 * xp + bb; xm = x0; x0 = xp; }
                u32x4 ov; ov.x = pk2(o[0], o[1]); ov.y = pk2(o[2], o[3]); ov.z = pk2(o[4], o[5]); ov.w = pk2(o[6], o[7]);
                *(u32x4*)(dst + g * 8) = ov; }
        }
    }
    __syncthreads();
    {
        const float* cw = P.in[I_MCW] + (size_t)l * 3 * 512; const float* cb = P.in[I_MCB] + (size_t)l * 512;
        bf16* MLQ = WSP(bf16, WS_MLQ); bf16* MLK = WSP(bf16, WS_MLK);
        const int gt = F.bid * NTHREADS + F.tid, NGT = F.G * NTHREADS;
        float cw0[8], cw1[8], cw2[8], cbb[8];
        { const int colh = (gt & 63) * 8;
#pragma unroll
          for (int h4 = 0; h4 < 2; ++h4) { const f32x4 a4 = *(const f32x4*)(cw + colh + 4 * h4), c4 = *(const f32x4*)(cw + 512 + colh + 4 * h4), d4 = *(const f32x4*)(cw + 1024 + colh + 4 * h4), b4 = *(const f32x4*)(cb + colh + 4 * h4);
              cw0[4 * h4] = a4.x; cw0[4 * h4 + 1] = a4.y; cw0[4 * h4 + 2] = a4.z; cw0[4 * h4 + 3] = a4.w; cw1[4 * h4] = c4.x; cw1[4 * h4 + 1] = c4.y; cw1[4 * h4 + 2] = c4.z; cw1[4 * h4 + 3] = c4.w;
              cw2[4 * h4] = d4.x; cw2[4 * h4 + 1] = d4.y; cw2[4 * h4 + 2] = d4.z; cw2[4 * h4 + 3] = d4.w; cbb[4 * h4] = b4.x; cbb[4 * h4 + 1] = b4.y; cbb[4 * h4 + 2] = b4.z; cbb[4 * h4 + 3] = b4.w; } }
        for (int idx0 = gt; idx0 < MTOT * 64; idx0 += 4 * NGT) {
            u32x4 v0[4], v1[4], v2[4];
#pragma unroll
            for (int q4 = 0; q4 < 4; ++q4) { const int idx = idx0 + q4 * NGT; v0[q4] = (u32x4){0u, 0u, 0u, 0u}; v1[q4] = v0[q4]; v2[q4] = v0[q4];
                if (idx < MTOT * 64) { const int row = idx >> 6, col = (idx & 63) * 8;
                    const int tin = row < NLAT ? (row & 4095) : ((row - NLAT) & 255); const int Ls = row < NLAT ? SEQ : CTXL;
                    const bf16* up = U + (size_t)row * UW + U_MLQ + col;
                    v1[q4] = *(const u32x4*)up; if (tin > 0) v0[q4] = *(const u32x4*)(up - UW); if (tin < Ls - 1) v2[q4] = *(const u32x4*)(up + UW); } }
#pragma unroll
            for (int q4 = 0; q4 < 4; ++q4) { const int idx = idx0 + q4 * NGT;
                if (idx < MTOT * 64) { const int row = idx >> 6, col = (idx & 63) * 8;
                    float a[8], c[8], d[8], o[8]; PU_UNPK(v0[q4], a); PU_UNPK(v1[q4], c); PU_UNPK(v2[q4], d);
                    const float sc = (col >= 256) ? 0.125f : 1.f;
#pragma unroll
                    for (int q = 0; q < 8; ++q) o[q] = siluf(cw0[q] * a[q] + cw1[q] * c[q] + cw2[q] * d[q] + cbb[q]) * sc;
                    u32x4 ov; ov.x = pk2(o[0], o[1]); ov.y = pk2(o[2], o[3]); ov.z = pk2(o[4], o[5]); ov.w = pk2(o[6], o[7]);
                    *(u32x4*)(((col >= 256) ? MLK : MLQ) + (size_t)row * 256 + (col & 255)) = ov; } }
        }
    }
}
#undef PU_UNPK

__device__ __forceinline__ void ph_taps(Frame& F, int l) {
    const CAS Params& P = *F.p;
    float* hs = (float*)F.lds;
    float* ws = hs + 64 * 65;
    const float* h2 = WSP(float, WS_H2L) + (size_t)l * 4096 * 64; const float* w3 = P.in[I_FW3] + (size_t)l * 64 * 1024; const float* b3 = P.in[I_FB3] + (size_t)l * 1024;
    float* TAPS = WSP(float, WS_TAPS);
    const float lo = logf(0.01f) / 1.5f, hi = logf(0.01f) / 0.3f;
    for (int it = F.bid; it < 64 * 16; it += F.G) {
        const int tb = it >> 4, cbk = it & 15, t0 = tb * 64, c0 = cbk * 64;
        for (int i = F.tid; i < 64 * 16; i += NTHREADS) { const int r = i >> 4, q = i & 15; const f32x4 v = *(const f32x4*)(h2 + (size_t)(t0 + r) * 64 + q * 4);
            hs[r * 65 + q * 4] = v.x; hs[r * 65 + q * 4 + 1] = v.y; hs[r * 65 + q * 4 + 2] = v.z; hs[r * 65 + q * 4 + 3] = v.w; }
        for (int i = F.tid; i < 64 * 16; i += NTHREADS) { const int k = i >> 4, q = i & 15; *(f32x4*)(ws + k * 64 + q * 4) = *(const f32x4*)(w3 + (size_t)k * 1024 + c0 + q * 4); }
        __syncthreads();
        { const int tq = F.tid & 63, cg = (F.tid >> 6) * 8; float acc[8];
#pragma unroll
          for (int q = 0; q < 8; ++q) acc[q] = b3[c0 + cg + q];
#pragma unroll 8
          for (int k = 0; k < 64; ++k) { const float h = hs[tq * 65 + k]; const f32x4 wa = *(const f32x4*)(ws + k * 64 + cg), wb = *(const f32x4*)(ws + k * 64 + cg + 4);
              acc[0] += h * wa.x; acc[1] += h * wa.y; acc[2] += h * wa.z; acc[3] += h * wa.w; acc[4] += h * wb.x; acc[5] += h * wb.y; acc[6] += h * wb.z; acc[7] += h * wb.w; }
          const float tn = (float)(t0 + tq) / 4095.f;
#pragma unroll
          for (int q = 0; q < 8; ++q) { const int col = c0 + cg + q; const float delta = fabsf(lo + (hi - lo) * ((float)(col & 255) / 255.f));
              TAPS[(size_t)col * 4096 + t0 + tq] = acc[q] * expf(-tn * delta); } }
        __syncthreads();
    }
}
__device__ __forceinline__ void hy_taps(Frame& F, int l, int o, int c, int L, const float* h2tab, float* T, float* red  , const float* pre = nullptr  ) {
    const CAS Params& P = *F.p;
    const float* w3 = P.in[I_FW3] + (size_t)l * 64 * 1024; const float* b3 = P.in[I_FB3] + (size_t)l * 1024;
    if (F.tid < 128) { const int dir = F.tid >> 6, k = F.tid & 63; red[F.tid] = w3[(size_t)k * 1024 + o * 512 + dir * 256 + c]; }
    if (F.tid < 2) red[128 + F.tid] = b3[o * 512 + F.tid * 256 + c];
    if (F.tid == 0) T[0] = 0.f;
    __syncthreads();
    const float lo = logf(0.01f) / 1.5f, hi = logf(0.01f) / 0.3f;
    const float delta = fabsf(lo + (hi - lo) * ((float)c / 255.f));
    float asum = 0.f;
    if (pre) {
        const float* p0 = pre + (size_t)(o * 512 + c) * L; const float* p1 = pre + (size_t)(o * 512 + 256 + c) * L;
        for (int t4 = F.tid * 4; t4 < L; t4 += NTHREADS * 4) { const f32x4 a = *(const f32x4*)(p0 + t4), bq = *(const f32x4*)(p1 + t4);
            T[L + t4] = a.x; T[L + t4 + 1] = a.y; T[L + t4 + 2] = a.z; T[L + t4 + 3] = a.w; asum += (fabsf(a.x) + fabsf(a.y)) + (fabsf(a.z) + fabsf(a.w));
            if (t4 >= 1) { T[L - t4] = bq.x; asum += fabsf(bq.x); } T[L - t4 - 1] = bq.y; T[L - t4 - 2] = bq.z; T[L - t4 - 3] = bq.w; asum += fabsf(bq.y) + fabsf(bq.z) + fabsf(bq.w); }
    } else
    for (int t = F.tid; t < L; t += NTHREADS) {
        const f32x4* hrow = (const f32x4*)(h2tab + (size_t)t * 64); float a0 = red[128], a1 = red[129];
#pragma unroll
        for (int k4 = 0; k4 < 16; ++k4) { const f32x4 h = hrow[k4]; const f32x4 w0 = *(const f32x4*)(red + 4 * k4), w1 = *(const f32x4*)(red + 64 + 4 * k4);
            a0 += (h.x * w0.x + h.y * w0.y) + (h.z * w0.z + h.w * w0.w); a1 += (h.x * w1.x + h.y * w1.y) + (h.z * w1.z + h.w * w1.w); }
        const float tn = (float)t / (float)(L - 1); const float dec = expf(-tn * delta);
        a0 *= dec; a1 *= dec;
        T[L + t] = a0; asum += fabsf(a0);
        if (t >= 1) { T[L - t] = a1; asum += fabsf(a1); }
    }
    asum = wave_sum(asum);
    __syncthreads();
    if (F.lane == 0) red[132 + F.wave] = asum;
    __syncthreads();
    float tot = 0.f;
#pragma unroll
    for (int w = 0; w < 8; ++w) tot += red[132 + w];
    const float inv = 1.f / tot;
    for (int idx = F.tid; idx < 2 * L; idx += NTHREADS) T[idx] *= inv;
    __syncthreads();
}
__device__ __forceinline__ void hy_naive_item(Frame& F, int l, int c, int b, int L, const float* h2tab, const bf16* V, const bf16* X1, const bf16* X2, bf16* Y) {
    const CAS Params& P = *F.p;
    float* T = (float*)F.lds;
    float* z = T + 2 * L;
    float* red = z + L;
    const size_t base = ((size_t)c * 8 + b) * L;
    for (int i = F.tid; i < L; i += NTHREADS) z[i] = bf2f(V[base + i]);
    const int per = L / NTHREADS > 0 ? L / NTHREADS : 1;
    for (int o = 0; o < 2; ++o) {
        hy_taps(F, l, o, c, L, h2tab, T, red);
        const float dd = P.in[I_HBD][(size_t)l * 512 + o * 256 + c];
        const bf16* G = (o == 0) ? X1 : X2;
        float res[8];
#pragma unroll
        for (int q = 0; q < 8; ++q) res[q] = 0.f;
        if (F.tid < L) {
            for (int s = 0; s < L; ++s) { const float zs = z[s];
#pragma unroll
                for (int q = 0; q < 8; ++q) if (q < per) { const int t = F.tid + q * NTHREADS; res[q] += T[t - s + L] * zs; } }
#pragma unroll
            for (int q = 0; q < 8; ++q) if (q < per) { const int t = F.tid + q * NTHREADS; res[q] = bf2f(G[base + t]) * (res[q] + dd * z[t]); }
        }
        __syncthreads();
        if (F.tid < L) {
#pragma unroll
            for (int q = 0; q < 8; ++q) if (q < per) { const int t = F.tid + q * NTHREADS; if (o == 0) z[t] = bf2f(f2bf(res[q])); else Y[base + t] = f2bf(res[q]); }
        }
        __syncthreads();
    }
}

namespace hy {
typedef short bf16x8 __attribute__((ext_vector_type(8)));
typedef float f32x16 __attribute__((ext_vector_type(16)));
constexpr int ZP = 5000, ZPAD = 448;
constexpr int Z_OFF = 0, RA_OFF = 80000, RB_OFF = 80000 + 16384 + 68, TF_OFF = 112896, RED_OFF = TF_OFF + 32768;
__device__ __forceinline__ int crow(int r, int hi) { return (r & 3) + 8 * (r >> 2) + 4 * hi; }
__device__ __forceinline__ void unit(Frame& F, int l, int c) {
    const Params CAS& P = *F.p;
    bf16* Z = (bf16*)(F.lds + Z_OFF); bf16* RA = (bf16*)(F.lds + RA_OFF); bf16* RB = (bf16*)(F.lds + RB_OFF); float* Tf = (float*)(F.lds + TF_OFF); float* red = (float*)(F.lds + RED_OFF);
    const bf16* V = WSP(bf16, WS_HYV) + (size_t)c * 8 * SEQ; const float* h2tab = WSP(float, WS_H2L) + (size_t)l * 4096 * 64;
    const int lane = F.lane, r32 = lane & 31, hi = lane >> 5, w = F.wave;
#pragma unroll
    for (int it8 = 0; it8 < 8; ++it8) { const int i = F.tid + it8 * NTHREADS; const int b = i >> 9, q = i & 511; *(u32x4*)(Z + b * ZP + ZPAD + q * 8) = *(const u32x4*)(V + (size_t)b * SEQ + q * 8); }
    for (int i = F.tid; i < 8 * 2 * (ZPAD / 8); i += NTHREADS) { const int b = i / (2 * (ZPAD / 8)), q = i % (2 * (ZPAD / 8)); const int off = (q < ZPAD / 8) ? q * 8 : ZPAD + SEQ + (q - ZPAD / 8) * 8;
        *(u32x4*)(Z + b * ZP + off) = (u32x4){0u, 0u, 0u, 0u}; }
    for (int o = 0; o < 2; ++o) {
        hy_taps(F, l, o, c, SEQ, h2tab, Tf, red, WSP(float, WS_TAPS));
        for (int k = F.tid; k < 8192; k += NTHREADS) { const float a = (k >= 1) ? Tf[8192 - k] : 0.f; const float bq = (k + 1 <= 8191) ? Tf[8192 - (k + 1)] : 0.f; RA[k] = f2bf(a); RB[k] = f2bf(bq); }
        __syncthreads();
        f32x16 acc[2][2];
#pragma unroll
        for (int cb = 0; cb < 2; ++cb)
#pragma unroll
            for (int rh = 0; rh < 2; ++rh) acc[cb][rh] = f32x16{};
        const unsigned* RAw = (const unsigned*)RA; const unsigned* RBw = (const unsigned*)RB;
        const int nb = r32 & 7, ntb = r32 >> 3;
        const bf16* zb = Z + nb * ZP + ZPAD + (8 * w + ntb) * 64 + 8 * hi;
        for (int dl = 8 * w - 63; dl <= 8 * w + 7; ++dl) {
            bf16x8 af[6];
#pragma unroll
            for (int q = 0; q < 6; ++q) { const int mm = 4 * dl + (q - 3); const int k0 = 4096 - 16 * mm + 8 * hi - r32; const int par = k0 & 1; const unsigned* src = (par ? RBw : RAw) + ((k0 - par) >> 1);
                u32x4 v; v.x = src[0]; v.y = src[1]; v.z = src[2]; v.w = src[3]; af[q] = __builtin_bit_cast(bf16x8, v); }
#pragma unroll
            for (int cb = 0; cb < 2; ++cb)
#pragma unroll
                for (int ks = 0; ks < 4; ++ks) { const bf16x8 bf = *(const bf16x8*)(zb + (4 * cb - dl) * 64 + 16 * ks);
#pragma unroll
                    for (int rh = 0; rh < 2; ++rh) acc[cb][rh] = __builtin_amdgcn_mfma_f32_32x32x16_bf16(af[2 * rh - ks + 3], bf, acc[cb][rh], 0, 0, 0); }
        }
        __syncthreads();
        const float dd = P.in[I_HBD][(size_t)l * 512 + o * 256 + c];
        const bf16* G = WSP(bf16, o == 0 ? WS_HYX1 : WS_HYX2) + ((size_t)c * 8 + nb) * SEQ; bf16* Y = WSP(bf16, WS_HYY) + ((size_t)c * 8 + nb) * SEQ;
        u32x2 gvv[2][2][4];
#pragma unroll
        for (int cb = 0; cb < 2; ++cb)
#pragma unroll
            for (int rh = 0; rh < 2; ++rh)
#pragma unroll
                for (int g = 0; g < 4; ++g) gvv[cb][rh][g] = *(const u32x2*)(G + (8 * w + 4 * cb + ntb) * 64 + 32 * rh + 8 * g + 4 * hi);
        __builtin_amdgcn_sched_barrier(0);
#pragma unroll
        for (int cb = 0; cb < 2; ++cb)
#pragma unroll
            for (int rh = 0; rh < 2; ++rh)
#pragma unroll
                for (int g = 0; g < 4; ++g) { const int t = (8 * w + 4 * cb + ntb) * 64 + 32 * rh + 8 * g + 4 * hi;
                    const u32x2 zi = *(const u32x2*)(Z + nb * ZP + ZPAD + t), gv = gvv[cb][rh][g];
                    const float r0 = __uint_as_float(gv.x << 16) * (acc[cb][rh][4 * g + 0] + dd * __uint_as_float(zi.x << 16)), r1 = __uint_as_float(gv.x & 0xffff0000u) * (acc[cb][rh][4 * g + 1] + dd * __uint_as_float(zi.x & 0xffff0000u));
                    const float r2 = __uint_as_float(gv.y << 16) * (acc[cb][rh][4 * g + 2] + dd * __uint_as_float(zi.y << 16)), r3 = __uint_as_float(gv.y & 0xffff0000u) * (acc[cb][rh][4 * g + 3] + dd * __uint_as_float(zi.y & 0xffff0000u));
                    u32x2 ov; ov.x = cvtpk(r0, r1); ov.y = cvtpk(r2, r3);
                    if (o == 0) *(u32x2*)(Z + nb * ZP + ZPAD + t) = ov; else *(u32x2*)(Y + t) = ov; }
        __syncthreads();
    }
}
}

__device__ __forceinline__ void ml_naive_item(Frame& F, int b, int hh, int dir) {
    const bf16* MLQ = WSP(bf16, WS_MLQ); const bf16* MLK = WSP(bf16, WS_MLK); const bf16* U = WSP(bf16, WS_U); const float* GT = WSP(float, WS_GATES);
    bf16* MLH = WSP(bf16, WS_MLH) + (size_t)dir * MTOT * 256;
    const int i = F.tid >> 3, jg = F.tid & 7;
    float C[8], n[8]; float m = 0.f;
#pragma unroll
    for (int q = 0; q < 8; ++q) { C[q] = 0.f; n[q] = 0.f; }
    for (int step = 0; step < CTXL + SEQ; ++step) {
        long row;
        if (step < CTXL) { const int t = dir ? (CTXL - 1 - step) : step; row = NLAT + (long)b * CTXL + t; }
        else { const int s2 = step - CTXL; const int t = dir ? (SEQ - 1 - s2) : s2; row = (long)b * SEQ + t; }
        const u32x4 kq = *(const u32x4*)(MLK + row * 256 + hh * 64 + jg * 8), qq = *(const u32x4*)(MLQ + row * 256 + hh * 64 + jg * 8);
        const float v = bf2f(U[row * UW + U_MLV + hh * 64 + i]);
        const float ig = GT[row * 16 + dir * 8 + hh], fg = GT[row * 16 + dir * 8 + 4 + hh];
        float kf[8], qf[8];
        kf[0] = __uint_as_float(kq.x << 16); kf[1] = __uint_as_float(kq.x & 0xffff0000u); kf[2] = __uint_as_float(kq.y << 16); kf[3] = __uint_as_float(kq.y & 0xffff0000u);
        kf[4] = __uint_as_float(kq.z << 16); kf[5] = __uint_as_float(kq.z & 0xffff0000u); kf[6] = __uint_as_float(kq.w << 16); kf[7] = __uint_as_float(kq.w & 0xffff0000u);
        qf[0] = __uint_as_float(qq.x << 16); qf[1] = __uint_as_float(qq.x & 0xffff0000u); qf[2] = __uint_as_float(qq.y << 16); qf[3] = __uint_as_float(qq.y & 0xffff0000u);
        qf[4] = __uint_as_float(qq.z << 16); qf[5] = __uint_as_float(qq.z & 0xffff0000u); qf[6] = __uint_as_float(qq.w << 16); qf[7] = __uint_as_float(qq.w & 0xffff0000u);
        const float lf = logsigmoidf(fg);
        const float mn = fmaxf(lf + m, ig);
        const float so = expf(lf + m - mn), sl = expf(ig - mn);
        float num = 0.f, den = 0.f;
#pragma unroll
        for (int q = 0; q < 8; ++q) { C[q] = so * C[q] + sl * v * kf[q]; n[q] = so * n[q] + sl * kf[q]; num += C[q] * qf[q]; den += n[q] * qf[q]; }
        m = mn;
        num += __shfl_xor(num, 1); num += __shfl_xor(num, 2); num += __shfl_xor(num, 4);
        den += __shfl_xor(den, 1); den += __shfl_xor(den, 2); den += __shfl_xor(den, 4);
        if (jg == 0) MLH[row * 256 + hh * 64 + i] = f2bf(num / fmaxf(fabsf(den), expf(-mn)));
    }
}

namespace ml {
typedef short bf16x8 __attribute__((ext_vector_type(8)));
typedef short s16x4 __attribute__((ext_vector_type(4)));
typedef short v4i16_t __attribute__((ext_vector_type(4)));
typedef float f32x16 __attribute__((ext_vector_type(16)));
typedef __attribute__((address_space(3))) const char* lds_cptr;
__device__ __forceinline__ int crow(int r, int hi) { return (r & 3) + 8 * (r >> 2) + 4 * hi; }
__device__ __forceinline__ long slot_row0(int b, int slot) { return slot < 4 ? (long)NLAT + (long)b * CTXL + slot * 64 : (long)b * SEQ + (long)(slot - 4) * 64; }
__device__ __forceinline__ float scan_add(float v, int lane) {
#pragma unroll
    for (int o = 1; o < 64; o <<= 1) { const float t = __shfl_up(v, o); if (lane >= o) v += t; }
    return v; }
__device__ __forceinline__ float scan_max_up(float v, int lane) {
#pragma unroll
    for (int o = 1; o < 64; o <<= 1) { const float t = __shfl_up(v, o); if (lane >= o) v = fmaxf(v, t); }
    return v; }
__device__ __forceinline__ float scan_max_dn(float v, int lane) {
#pragma unroll
    for (int o = 1; o < 64; o <<= 1) { const float t = __shfl_down(v, o); if (lane + o < 64) v = fmaxf(v, t); }
    return v; }
__device__ __forceinline__ float wave_max(float v) {
#pragma unroll
    for (int o = 1; o < 64; o <<= 1) v = fmaxf(v, __shfl_xor(v, o));
    return v; }
__device__ __forceinline__ float swapadd(float m) { auto rr = __builtin_amdgcn_permlane32_swap(__float_as_uint(m), __float_as_uint(m), false, false); return __uint_as_float(rr[0]) + __uint_as_float(rr[1]); }
__device__ __forceinline__ int img_off(int row, int col8) { return ((col8 >> 2) * 4 + (row >> 4)) * 1024 + (row & 15) * 64 + (col8 & 3) * 16; }
__device__ __forceinline__ bf16x8 tr_frag(lds_cptr img, int cb, int ks, int lane) {
    const int hi = lane >> 5;
    const lds_cptr p = img + (cb * 4 + ks) * 1024 + (4 * hi + ((lane & 15) >> 2)) * 64 + ((lane >> 4) & 1) * 32 + (lane & 3) * 8;
    const s16x4 lo = __builtin_bit_cast(s16x4, __builtin_amdgcn_ds_read_tr16_b64_v4i16((__attribute__((address_space(3))) v4i16_t*)p));
    const s16x4 hv = __builtin_bit_cast(s16x4, __builtin_amdgcn_ds_read_tr16_b64_v4i16((__attribute__((address_space(3))) v4i16_t*)(p + 512)));
    return (bf16x8){lo[0], lo[1], lo[2], lo[3], hv[0], hv[1], hv[2], hv[3]};
}
#define ML_UNPK(v, f) do { f[0] = __uint_as_float(v.x << 16); f[1] = __uint_as_float(v.x & 0xffff0000u); f[2] = __uint_as_float(v.y << 16); f[3] = __uint_as_float(v.y & 0xffff0000u); \
        f[4] = __uint_as_float(v.z << 16); f[5] = __uint_as_float(v.z & 0xffff0000u); f[6] = __uint_as_float(v.w << 16); f[7] = __uint_as_float(v.w & 0xffff0000u); } while (0)

__device__ __forceinline__ void s1_item(Frame& F, int l, int b, int hh, int slot, unsigned char* lw  , int dir_lo, int dir_hi) {
    const Params CAS& P = *F.p;
    const bf16* U = WSP(bf16, WS_U); const float* GT = WSP(float, WS_GATES);
    bf16* CST = WSP(bf16, WS_CST); float* NST = WSP(float, WS_NST); float* MLOC = WSP(float, WS_MLOC);
    const int lane = F.lane, r32 = lane & 31, hi = lane >> 5;
    const long row0 = slot_row0(b, slot), row = row0 + lane;
    const bool has_prev = !((slot == 0 || slot == 4) && lane == 0), has_next = !((slot == 3 || slot == 67) && lane == 63);
    unsigned char* Kimg = lw; unsigned char* Vimg = lw + 8192; float* es = (float*)(lw + 16384);
    const lds_cptr K3 = (lds_cptr)(__attribute__((address_space(3))) unsigned char*)Kimg; const lds_cptr V3 = (lds_cptr)(__attribute__((address_space(3))) unsigned char*)Vimg;
    float igv[2], fgv[2];
#pragma unroll
    for (int d_ = 0; d_ < 2; ++d_) { igv[d_] = GT[row * 16 + d_ * 8 + hh]; fgv[d_] = GT[row * 16 + d_ * 8 + 4 + hh]; }
    { const int rsub = lane >> 3, cq = lane & 7;
      const float* cw = P.in[I_MCW] + (size_t)l * 3 * 512 + 256 + hh * 64 + cq * 8; const float* cb = P.in[I_MCB] + (size_t)l * 512 + 256 + hh * 64 + cq * 8;
      float w0[8], w1[8], w2[8], bb[8];
#pragma unroll
      for (int h4 = 0; h4 < 2; ++h4) { const f32x4 a4 = *(const f32x4*)(cw + 4 * h4), c4 = *(const f32x4*)(cw + 512 + 4 * h4), d4 = *(const f32x4*)(cw + 1024 + 4 * h4), b4 = *(const f32x4*)(cb + 4 * h4);
          w0[4 * h4] = a4.x; w0[4 * h4 + 1] = a4.y; w0[4 * h4 + 2] = a4.z; w0[4 * h4 + 3] = a4.w; w1[4 * h4] = c4.x; w1[4 * h4 + 1] = c4.y; w1[4 * h4 + 2] = c4.z; w1[4 * h4 + 3] = c4.w;
          w2[4 * h4] = d4.x; w2[4 * h4 + 1] = d4.y; w2[4 * h4 + 2] = d4.z; w2[4 * h4 + 3] = d4.w; bb[4 * h4] = b4.x; bb[4 * h4 + 1] = b4.y; bb[4 * h4 + 2] = b4.z; bb[4 * h4 + 3] = b4.w; }
      const bf16* up = U + (size_t)(row0 + rsub) * UW + U_MLK + hh * 64 + cq * 8;
      u32x4 t0[8], t1[8], t2[8];
#pragma unroll
      for (int i = 0; i < 8; ++i) { const int rl = i * 8 + rsub;
          const bool hp = !((slot == 0 || slot == 4) && rl == 0), hn = !((slot == 3 || slot == 67) && rl == 63);
          const bf16* pc = up + (size_t)i * 8 * UW;
          t1[i] = *(const u32x4*)pc; t0[i] = *(const u32x4*)(hp ? pc - UW : pc); t2[i] = *(const u32x4*)(hn ? pc + UW : pc); }
#pragma unroll
      for (int i = 0; i < 8; ++i) { const int rl = i * 8 + rsub;
          const bool hp = !((slot == 0 || slot == 4) && rl == 0), hn = !((slot == 3 || slot == 67) && rl == 63);
          const u32x4 z4 = (u32x4){0u, 0u, 0u, 0u}; const u32x4 v0 = hp ? t0[i] : z4, v1 = t1[i], v2 = hn ? t2[i] : z4;
          float a[8], c[8], d[8], o[8]; ML_UNPK(v0, a); ML_UNPK(v1, c); ML_UNPK(v2, d);
#pragma unroll
          for (int q = 0; q < 8; ++q) o[q] = siluf(w0[q] * a[q] + w1[q] * c[q] + w2[q] * d[q] + bb[q]) * 0.125f;
          u32x4 w; w.x = pk2(o[0], o[1]); w.y = pk2(o[2], o[3]); w.z = pk2(o[4], o[5]); w.w = pk2(o[6], o[7]);
          *(u32x4*)(Kimg + img_off(rl, cq)) = w; } }
    u32x4 vraw[8];
    { const int rsub = lane >> 3, cq = lane & 7; const bf16* vp = U + (size_t)(row0 + rsub) * UW + U_MLV + hh * 64 + cq * 8;
#pragma unroll
      for (int i = 0; i < 8; ++i) vraw[i] = *(const u32x4*)(vp + (size_t)i * 8 * UW); }
#pragma unroll 1
    for (int dir = dir_lo; dir < dir_hi; ++dir) {
        const int seq = (b * 4 + hh) * 2 + dir;
        const float ig = (dir == 0) ? igv[0] : igv[1], fg = (dir == 0) ? fgv[0] : fgv[1];
        const float lf = logsigmoidf(fg); const float bc = scan_add(lf, lane); const float tot = __shfl(bc, 63);
        const float a = (dir == 0) ? (tot - bc + ig) : (bc - lf + ig);
        const float mloc = wave_max(a); const float e = __expf(a - mloc);
        asm volatile("s_waitcnt lgkmcnt(0)" ::: "memory");
        es[lane] = e;
        asm volatile("s_waitcnt lgkmcnt(0)" ::: "memory");
        { const int rsub = lane >> 3, cq = lane & 7;
#pragma unroll
          for (int i = 0; i < 8; ++i) { const u32x4 v = vraw[i]; const float er = es[i * 8 + rsub]; float f[8]; ML_UNPK(v, f);
              u32x4 w; w.x = pk2(f[0] * er, f[1] * er); w.y = pk2(f[2] * er, f[3] * er); w.z = pk2(f[4] * er, f[5] * er); w.w = pk2(f[6] * er, f[7] * er);
              *(u32x4*)(Vimg + img_off(i * 8 + rsub, cq)) = w; } }
        asm volatile("s_waitcnt lgkmcnt(0)" ::: "memory");
        f32x16 acc[2][2];
#pragma unroll
        for (int jb = 0; jb < 2; ++jb)
#pragma unroll
            for (int ib = 0; ib < 2; ++ib) acc[jb][ib] = f32x16{};
#pragma unroll
        for (int ls = 0; ls < 4; ++ls) { bf16x8 ka[2], vb[2];
#pragma unroll
            for (int q = 0; q < 2; ++q) { ka[q] = tr_frag(K3, q, ls, lane); vb[q] = tr_frag(V3, q, ls, lane); }
#pragma unroll
            for (int jb = 0; jb < 2; ++jb)
#pragma unroll
                for (int ib = 0; ib < 2; ++ib) acc[jb][ib] = __builtin_amdgcn_mfma_f32_32x32x16_bf16(ka[jb], vb[ib], acc[jb][ib], 0, 0, 0); }
        bf16* cdst = CST + ((size_t)seq * 68 + slot) * 4096;
#pragma unroll
        for (int jb = 0; jb < 2; ++jb)
#pragma unroll
            for (int ib = 0; ib < 2; ++ib)
#pragma unroll
                for (int g = 0; g < 4; ++g) { u32x2 ov; ov.x = cvtpk(acc[jb][ib][4 * g], acc[jb][ib][4 * g + 1]); ov.y = cvtpk(acc[jb][ib][4 * g + 2], acc[jb][ib][4 * g + 3]);
                    *(u32x2*)(cdst + (32 * ib + r32) * 64 + 32 * jb + 8 * g + 4 * hi) = ov; }
        { float nl = 0.f; const unsigned short* kc = (const unsigned short*)(Kimg + ((lane >> 5) * 4) * 1024 + ((lane & 31) >> 3) * 16 + (lane & 7) * 2);
#pragma unroll 8
          for (int ll = 0; ll < 64; ++ll) nl += es[ll] * bf2f(kc[(ll >> 4) * 512 + (ll & 15) * 32]);
          NST[((size_t)seq * 68 + slot) * 64 + lane] = nl; }
        if (lane == 0) { MLOC[((size_t)seq * 68 + slot) * 2] = mloc; MLOC[((size_t)seq * 68 + slot) * 2 + 1] = tot; }
    }
}
__device__ __forceinline__ void s2_item(Frame& F, int seq, int rg) {
    bf16* CST = WSP(bf16, WS_CST) + (size_t)seq * 68 * 4096; float* NST = WSP(float, WS_NST) + (size_t)seq * 68 * 64; const float* MLOC = WSP(float, WS_MLOC) + (size_t)seq * 68 * 2; float* MENT = WSP(float, WS_MENT) + (size_t)seq * 68;
    const int lane = F.lane, dir = seq & 1;
    const int eoff = (rg * 8 + (lane >> 3)) * 64 + (lane & 7) * 8;
    float C[8], n = 0.f, m = 0.f;
#pragma unroll
    for (int q = 0; q < 8; ++q) C[q] = 0.f;
#define ML_SLOT(st) ((dir == 0) ? (st) : (((st) < 4) ? 3 - (st) : 71 - (st)))
#pragma unroll 1
    for (int st0 = 0; st0 < 68; st0 += 17) {
        u32x4 xb[17]; float nlb[17]; float mlb[17], blb[17];
#pragma unroll
        for (int i = 0; i < 17; ++i) { const int slot = ML_SLOT(st0 + i);
            xb[i] = *(const u32x4*)(CST + (size_t)slot * 4096 + eoff); nlb[i] = (lane < 8) ? NST[slot * 64 + rg * 8 + lane] : 0.f; mlb[i] = MLOC[slot * 2]; blb[i] = MLOC[slot * 2 + 1]; }
#pragma unroll
        for (int i = 0; i < 17; ++i) { const int cs = ML_SLOT(st0 + i);
            u32x4 w; w.x = pk2(C[0], C[1]); w.y = pk2(C[2], C[3]); w.z = pk2(C[4], C[5]); w.w = pk2(C[6], C[7]);
            *(u32x4*)(CST + (size_t)cs * 4096 + eoff) = w;
            if (lane < 8) NST[cs * 64 + rg * 8 + lane] = n;
            if (rg == 0 && lane == 0) MENT[cs] = m;
            const float mn = fmaxf(blb[i] + m, mlb[i]); const float so = __expf(blb[i] + m - mn), sl = __expf(mlb[i] - mn);
            float f[8]; ML_UNPK(xb[i], f);
#pragma unroll
            for (int q = 0; q < 8; ++q) C[q] = so * C[q] + sl * f[q];
            n = so * n + sl * nlb[i]; m = mn; }
    }
#undef ML_SLOT
}
__device__ __forceinline__ void s3_item(Frame& F, int l, int b, int hh, int slot, unsigned char* lw  ) {
    const Params CAS& P = *F.p;
    const bf16* U = WSP(bf16, WS_U); const float* GT = WSP(float, WS_GATES); const bf16* MLQ = WSP(bf16, WS_MLQ); const bf16* MLK = WSP(bf16, WS_MLK);
    const bf16* CST = WSP(bf16, WS_CST); const float* NST = WSP(float, WS_NST); const float* MENT = WSP(float, WS_MENT); bf16* MIX = WSP(bf16, WS_HB);
    const int lane = F.lane, r32 = lane & 31, hi = lane >> 5;
    const long row0 = slot_row0(b, slot), row = row0 + lane;
    unsigned char* Vimg = lw; float* gs = (float*)(lw + 8192); float* n0s = gs + 128;
    const lds_cptr V3 = (lds_cptr)(__attribute__((address_space(3))) unsigned char*)Vimg;
    const size_t sidx0 = (size_t)((b * 4 + hh) * 2) * 68 + slot, sidx1 = sidx0 + 68;
    float ig[2], fg[2], n0v[2], m0[2];
#pragma unroll
    for (int dir = 0; dir < 2; ++dir) { ig[dir] = GT[row * 16 + dir * 8 + hh]; fg[dir] = GT[row * 16 + dir * 8 + 4 + hh]; }
    n0v[0] = NST[sidx0 * 64 + lane]; n0v[1] = NST[sidx1 * 64 + lane]; m0[0] = MENT[sidx0]; m0[1] = MENT[sidx1];
    asm volatile("s_waitcnt lgkmcnt(0)" ::: "memory");
    { const int rsub = lane >> 3, cq = lane & 7; const bf16* vp = U + (size_t)(row0 + rsub) * UW + U_MLV + hh * 64 + cq * 8;
#pragma unroll
      for (int i = 0; i < 8; ++i) *(u32x4*)(Vimg + img_off(i * 8 + rsub, cq)) = *(const u32x4*)(vp + (size_t)i * 8 * UW); }
    float btm[2], wi[2], emt[2];
#pragma unroll
    for (int dir = 0; dir < 2; ++dir) {
        const float lf = logsigmoidf(fg[dir]); const float bp = scan_add(lf, lane); const float tot = __shfl(bp, 63);
        const float bb = (dir == 0) ? bp : (tot - bp + lf);
        const float g = ig[dir] - bb; const float pm = (dir == 0) ? scan_max_up(g, lane) : scan_max_dn(g, lane);
        const float mt = bb + fmaxf(m0[dir], pm); wi[dir] = __expf(bb + m0[dir] - mt); btm[dir] = bb - mt; emt[dir] = __expf(-mt);
        gs[dir * 64 + lane] = g; n0s[dir * 64 + lane] = n0v[dir];
    }
    asm volatile("s_waitcnt lgkmcnt(0)" ::: "memory");
    const float* nw = P.in[I_MNW] + l * 256 + hh * 64;
#pragma unroll 1
    for (int th = 0; th < 2; ++th) {
        const int tl = 32 * th + r32;
        bf16x8 qf[4];
        f32x16 S[2]; S[0] = f32x16{}; S[1] = f32x16{};
        { bf16x8 kf[8];
#pragma unroll
          for (int ks = 0; ks < 4; ++ks)
#pragma unroll
              for (int sh = 0; sh < 2; ++sh) kf[2 * ks + sh] = *(const bf16x8*)(MLK + (size_t)(row0 + 32 * sh + r32) * 256 + hh * 64 + 16 * ks + 8 * hi);
#pragma unroll
          for (int ks = 0; ks < 4; ++ks) qf[ks] = *(const bf16x8*)(MLQ + (size_t)(row0 + tl) * 256 + hh * 64 + 16 * ks + 8 * hi);
#pragma unroll
          for (int ks = 0; ks < 4; ++ks)
#pragma unroll
              for (int sh = 0; sh < 2; ++sh) S[sh] = __builtin_amdgcn_mfma_f32_32x32x16_bf16(kf[2 * ks + sh], qf[ks], S[sh], 0, 0, 0); }
        f32x16 O[2]; O[0] = f32x16{}; O[1] = f32x16{};
#pragma unroll 1
        for (int dir = 0; dir < 2; ++dir) {
            const bf16* c0 = CST + (dir == 0 ? sidx0 : sidx1) * 4096;
            bf16x8 cfa[4];
#pragma unroll
            for (int ks = 0; ks < 4; ++ks) cfa[ks] = *(const bf16x8*)(c0 + r32 * 64 + 16 * ks + 8 * hi);
            const float btm_t = __shfl(dir == 0 ? btm[0] : btm[1], tl), wi_t = __shfl(dir == 0 ? wi[0] : wi[1], tl), emt_t = __shfl(dir == 0 ? emt[0] : emt[1], tl);
            float p[2][16]; float dsum = 0.f;
#pragma unroll
            for (int sh = 0; sh < 2; ++sh)
#pragma unroll
                for (int r = 0; r < 16; ++r) { const int sp = 32 * sh + crow(r, hi); const bool ok = (dir == 0) ? (sp <= tl) : (sp >= tl);
                    const float v = ok ? __expf(gs[dir * 64 + sp] + btm_t) * S[sh][r] : 0.f; p[sh][r] = v; dsum += v; }
            bf16x8 cfb[4];
#pragma unroll
            for (int ks = 0; ks < 4; ++ks) cfb[ks] = *(const bf16x8*)(c0 + (32 + r32) * 64 + 16 * ks + 8 * hi);
            float qn = 0.f;
#pragma unroll
            for (int ks = 0; ks < 4; ++ks) { float qv[8]; const u32x4 qq = __builtin_bit_cast(u32x4, qf[ks]); ML_UNPK(qq, qv);
#pragma unroll
                for (int q = 0; q < 8; ++q) qn += qv[q] * n0s[dir * 64 + 16 * ks + 8 * hi + q]; }
            const float den = swapadd(dsum) + wi_t * swapadd(qn);
            const float sc = __builtin_amdgcn_rcpf(fmaxf(fabsf(den), emt_t)), qsc = wi_t * sc;
            bf16x8 pf[4], qs[4];
#pragma unroll
            for (int ss = 0; ss < 4; ++ss) { const int sh = ss >> 1, r0 = 8 * (ss & 1); u32x4 w;
                w.x = cvtpk(p[sh][r0 + 0] * sc, p[sh][r0 + 1] * sc); w.y = cvtpk(p[sh][r0 + 2] * sc, p[sh][r0 + 3] * sc); w.z = cvtpk(p[sh][r0 + 4] * sc, p[sh][r0 + 5] * sc); w.w = cvtpk(p[sh][r0 + 6] * sc, p[sh][r0 + 7] * sc);
                pf[ss] = __builtin_bit_cast(bf16x8, w); }
#pragma unroll
            for (int ks = 0; ks < 4; ++ks) { float qv[8]; const u32x4 qq = __builtin_bit_cast(u32x4, qf[ks]); ML_UNPK(qq, qv); u32x4 w;
                w.x = cvtpk(qv[0] * qsc, qv[1] * qsc); w.y = cvtpk(qv[2] * qsc, qv[3] * qsc); w.z = cvtpk(qv[4] * qsc, qv[5] * qsc); w.w = cvtpk(qv[6] * qsc, qv[7] * qsc);
                qs[ks] = __builtin_bit_cast(bf16x8, w); }
#pragma unroll
            for (int ks = 0; ks < 4; ++ks) O[0] = __builtin_amdgcn_mfma_f32_32x32x16_bf16(cfa[ks], qs[ks], O[0], 0, 0, 0);
#pragma unroll
            for (int ss = 0; ss < 4; ++ss) O[0] = __builtin_amdgcn_mfma_f32_32x32x16_bf16(tr_frag(V3, 0, ss, lane), pf[ss], O[0], 0, 0, 0);
#pragma unroll
            for (int ks = 0; ks < 4; ++ks) O[1] = __builtin_amdgcn_mfma_f32_32x32x16_bf16(cfb[ks], qs[ks], O[1], 0, 0, 0);
#pragma unroll
            for (int ss = 0; ss < 4; ++ss) O[1] = __builtin_amdgcn_mfma_f32_32x32x16_bf16(tr_frag(V3, 1, ss, lane), pf[ss], O[1], 0, 0, 0);
        }
        float ss2 = 0.f;
#pragma unroll
        for (int ib = 0; ib < 2; ++ib)
#pragma unroll
            for (int r = 0; r < 16; ++r) ss2 += O[ib][r] * O[ib][r];
        const float rstd = rsqrtf(swapadd(ss2) * (1.f / 64.f) + EPS);
        const long orow = row0 + tl;
        u32x2 ogv[2][4]; f32x4 nwv[2][4];
#pragma unroll
        for (int ib = 0; ib < 2; ++ib)
#pragma unroll
            for (int g = 0; g < 4; ++g) { const int i0 = 32 * ib + 8 * g + 4 * hi; ogv[ib][g] = *(const u32x2*)(U + (size_t)orow * UW + U_MLO + hh * 64 + i0); nwv[ib][g] = *(const f32x4*)(nw + i0); }
        __builtin_amdgcn_sched_barrier(0);
#pragma unroll
        for (int ib = 0; ib < 2; ++ib)
#pragma unroll
            for (int g = 0; g < 4; ++g) { const int i0 = 32 * ib + 8 * g + 4 * hi; const u32x2 og = ogv[ib][g]; const f32x4 w = nwv[ib][g];
                const float o0 = sigmoidf(__uint_as_float(og.x << 16)) * O[ib][4 * g] * rstd * w.x, o1 = sigmoidf(__uint_as_float(og.x & 0xffff0000u)) * O[ib][4 * g + 1] * rstd * w.y;
                const float o2 = sigmoidf(__uint_as_float(og.y << 16)) * O[ib][4 * g + 2] * rstd * w.z, o3 = sigmoidf(__uint_as_float(og.y & 0xffff0000u)) * O[ib][4 * g + 3] * rstd * w.w;
                u32x2 ov; ov.x = cvtpk(o0, o1); ov.y = cvtpk(o2, o3);
                *(u32x2*)(MIX + (size_t)orow * DM + 256 + hh * 64 + i0) = ov; }
    }
}
#undef ML_UNPK
}
__device__ __forceinline__ void ph_ml_s1(Frame& F, int l) {
    const int gw = F.bid * NWAVES + F.wave, NGW = F.G * NWAVES;
    const bool stdg = (NGW == 2048);
    for (int k = 0; ; ++k) {
        const int it = stdg ? ((k == 0) ? gw : 2048 + (2047 - gw)) : gw + k * NGW;
        if (it >= 2048 + 256 || (stdg && k >= 2)) break;
        int bh, slot, dlo, dhi;
        if (it < 2048) { bh = it >> 6; slot = 4 + (it & 63); dlo = 0; dhi = 2; }
        else { const int r = it - 2048, q = r >> 1; dlo = r & 1; dhi = dlo + 1; bh = q >> 2; slot = q & 3; }
        ml::s1_item(F, l, bh >> 2, bh & 3, slot, F.lds + F.wave * 17408, dlo, dhi);
    }
}
__device__ __forceinline__ void ph_ml_s3(Frame& F, int l) {
    const int gw = F.bid * NWAVES + F.wave, NGW = F.G * NWAVES;
    const int s0 = (l == 0) ? 0 : 4, ns = 68 - s0;
    const bool stdg = (NGW == 2048);
    for (int k = 0; ; ++k) {
        const int it = stdg ? ((k == 0) ? gw : 2048 + (2047 - gw)) : gw + k * NGW;
        if (it >= 8 * 4 * ns || (stdg && k >= 2)) break;
        const int bh = it / ns, slot = s0 + it % ns; ml::s3_item(F, l, bh >> 2, bh & 3, slot, F.lds + F.wave * 10240);
    }
}

__device__ __forceinline__ void da_naive_item(Frame& F, int l, int b, int hh, long qrow0, int kt0, int kt1) {
    const CAS Params& P = *F.p;
    const bf16* U = WSP(bf16, WS_U); bf16* MIX = WSP(bf16, WS_HB);
    float* Qs = (float*)F.lds;
    float* Ks = Qs + 64 * 129;
    float* Vs = Ks + 64 * 129;
    float* Ps = Vs + 64 * 129;
    const int qi = F.tid >> 3, part = F.tid & 7;
    const float lam = WSP(float, WS_LAM)[l]; const float lam_init = 0.8f - 0.6f * expf(-0.3f * (float)l);
    for (int i = F.tid; i < 64 * 128; i += NTHREADS) { const int r = i >> 7, cc = i & 127; Qs[r * 129 + cc] = bf2f(U[(size_t)(qrow0 + r) * UW + U_DAQ + hh * 128 + cc]); }
    float M0 = -INFINITY, M1 = -INFINITY, L0 = 0.f, L1 = 0.f;
    for (int pass = 0; pass < 2; ++pass) {
        float o[16];
#pragma unroll
        for (int q = 0; q < 16; ++q) o[q] = 0.f;
        for (int kt = kt0; kt < kt1; ++kt) {
            const long krow0 = (kt < 64) ? ((long)b * SEQ + kt * 64) : (NLAT + (long)b * CTXL + (kt - 64) * 64);
            __syncthreads();
            for (int i = F.tid; i < 64 * 128; i += NTHREADS) { const int r = i >> 7, cc = i & 127; Ks[r * 129 + cc] = bf2f(U[(size_t)(krow0 + r) * UW + U_DAK + hh * 128 + cc]);
                if (pass) Vs[r * 129 + cc] = bf2f(U[(size_t)(krow0 + r) * UW + U_DAV + hh * 128 + cc]); }
            __syncthreads();
            float s0[8], s1[8];
#pragma unroll
            for (int kk = 0; kk < 8; ++kk) { s0[kk] = 0.f; s1[kk] = 0.f; }
            for (int d = 0; d < 64; ++d) { const float q0 = Qs[qi * 129 + d], q1 = Qs[qi * 129 + 64 + d];
#pragma unroll
                for (int kk = 0; kk < 8; ++kk) { const float* kr = Ks + (part * 8 + kk) * 129; s0[kk] += q0 * kr[d]; s1[kk] += q1 * kr[64 + d]; } }
            if (pass == 0) {
                float m0 = s0[0], m1 = s1[0];
#pragma unroll
                for (int kk = 1; kk < 8; ++kk) { m0 = fmaxf(m0, s0[kk]); m1 = fmaxf(m1, s1[kk]); }
                const float n0 = fmaxf(M0, m0), n1 = fmaxf(M1, m1);
                float a0 = 0.f, a1 = 0.f;
#pragma unroll
                for (int kk = 0; kk < 8; ++kk) { a0 += exp2f(s0[kk] - n0); a1 += exp2f(s1[kk] - n1); }
                L0 = L0 * exp2f(M0 - n0) + a0; L1 = L1 * exp2f(M1 - n1) + a1; M0 = n0; M1 = n1;
            } else {
#pragma unroll
                for (int kk = 0; kk < 8; ++kk) Ps[qi * 65 + part * 8 + kk] = exp2f(s0[kk] - M0) * L0 - lam * exp2f(s1[kk] - M1) * L1;
                __syncthreads();
                for (int k = 0; k < 64; ++k) { const float pv = Ps[qi * 65 + k]; const float* vr = Vs + k * 129 + part * 16;
#pragma unroll
                    for (int q = 0; q < 16; ++q) o[q] += pv * vr[q]; }
            }
        }
        if (pass == 0) {
#pragma unroll
            for (int sft = 1; sft < 8; sft <<= 1) {
                const float oM0 = __shfl_xor(M0, sft), oL0 = __shfl_xor(L0, sft), oM1 = __shfl_xor(M1, sft), oL1 = __shfl_xor(L1, sft);
                const float n0 = fmaxf(M0, oM0), n1 = fmaxf(M1, oM1);
                L0 = L0 * exp2f(M0 - n0) + oL0 * exp2f(oM0 - n0); L1 = L1 * exp2f(M1 - n1) + oL1 * exp2f(oM1 - n1); M0 = n0; M1 = n1;
            }
            L0 = 1.f / L0; L1 = 1.f / L1;
        } else {
            float ss = 0.f;
#pragma unroll
            for (int q = 0; q < 16; ++q) ss += o[q] * o[q];
            ss += __shfl_xor(ss, 1); ss += __shfl_xor(ss, 2); ss += __shfl_xor(ss, 4);
            const float rstd = rsqrtf(ss * (1.f / 128.f) + EPS) * (1.f - lam_init);
            const float* sw = P.in[I_SUBLN] + l * 128 + part * 16;
            bf16* dst = MIX + (size_t)(qrow0 + qi) * DM + 512 + hh * 128 + part * 16;
#pragma unroll
            for (int q = 0; q < 16; ++q) dst[q] = f2bf(o[q] * rstd * sw[q]);
        }
    }
    __syncthreads();
}

namespace da {
typedef short bf16x8 __attribute__((ext_vector_type(8)));
typedef short s16x4 __attribute__((ext_vector_type(4)));
typedef float f32x16 __attribute__((ext_vector_type(16)));
constexpr int KSLOT = 16384, VSLOT = 16384, VBASE = 65536, THR = 8;
__device__ __forceinline__ void glds16(const void* gsrc, unsigned lds_dst) { unsigned keep;
    asm volatile("s_mov_b32 %0, m0\n\ts_mov_b32 m0, %2\n\ts_nop 0\n\tglobal_load_lds_dwordx4 %1, off\n\ts_mov_b32 m0, %0" : "=&s"(keep) : "v"(gsrc), "s"(lds_dst) : "memory"); }
__device__ __forceinline__ float swapmax(float m) { auto rr = __builtin_amdgcn_permlane32_swap(__float_as_uint(m), __float_as_uint(m), false, false); return fmaxf(__uint_as_float(rr[0]), __uint_as_float(rr[1])); }
__device__ __forceinline__ float swapadd(float m) { auto rr = __builtin_amdgcn_permlane32_swap(__float_as_uint(m), __float_as_uint(m), false, false); return __uint_as_float(rr[0]) + __uint_as_float(rr[1]); }
template <int IMM> __device__ __forceinline__ void glds16s(const void* sbase, unsigned voff, unsigned lds_dst) { unsigned keep;
    asm volatile("s_mov_b32 %0, m0\n\ts_mov_b32 m0, %3\n\ts_nop 0\n\tglobal_load_lds_dwordx4 %1, %2 offset:%4\n\ts_mov_b32 m0, %0" : "=&s"(keep) : "v"(voff), "s"(sbase), "s"(lds_dst), "n"(IMM) : "memory"); }
#define DA_WAIT_BAR(N) asm volatile("s_waitcnt vmcnt(" #N ") lgkmcnt(0)\n\ts_barrier" ::: "memory")
typedef short v4i16_t __attribute__((ext_vector_type(4)));
template <int MW> __device__ __forceinline__ void unit_t(Frame& F, int l, int b_, int hh_, long qrow0_, int kt0_, int NT_) {
    const bf16* U = WSP(bf16, WS_U); bf16* MIX = WSP(bf16, WS_HB);
    const int b = __builtin_amdgcn_readfirstlane(b_), hh = __builtin_amdgcn_readfirstlane(hh_), kt0 = __builtin_amdgcn_readfirstlane(kt0_), NT = __builtin_amdgcn_readfirstlane(NT_);
    const long qrow0 = (long)__builtin_amdgcn_readfirstlane((int)qrow0_);
    int lane_ = F.lane; asm volatile("" : "+v"(lane_));
    constexpr int mw = MW;
    const int lane = lane_, r32 = lane & 31, hi = lane >> 5, wid = F.wave, rw = wid & 3;
    const unsigned lds0 = (unsigned)(uintptr_t)F.lds;
    typedef __attribute__((address_space(3))) const char* lds_cptr;
    const lds_cptr L3 = (lds_cptr)(__attribute__((address_space(3))) unsigned char*)F.lds;
    const unsigned kvo = (unsigned)(((lane >> 2) * UW + (((lane & 3) ^ ((lane >> 4) & 3)) * 8)) * 2), vvo = (unsigned)(((lane >> 2) * UW + (lane & 3) * 8) * 2);
    const char* const kwb = (const char*)(U + (size_t)((wid & 3) * 16) * UW + U_DAK + hh * 128 + (wid >> 2) * 32);
    const char* const vwb = (const char*)(U + (size_t)((2 * (wid & 1)) * 16) * UW + U_DAV + hh * 128 + (wid >> 1) * 32);
#define DA_KROW(kt) (((kt) < 64) ? ((long)b * SEQ + (long)(kt) * 64) : ((long)NLAT + (long)b * CTXL + (long)((kt) - 64) * 64))
#define DA_ISSUE(kt, ksl, vsl) do { const size_t ko_ = (size_t)DA_KROW(kt) * (UW * 2); const unsigned kd_ = lds0 + (unsigned)(ksl) * KSLOT + wid * 1024, vd_ = lds0 + VBASE + (unsigned)(vsl) * VSLOT + wid * 2048; \
        glds16s<0>(kwb + ko_, kvo, kd_); glds16s<128>(kwb + ko_, kvo, kd_ + 8192 - 128);         \
        glds16s<0>(vwb + ko_, vvo, vd_); glds16s<0>(vwb + ko_ + 16 * UW * 2, vvo, vd_ + 1024); } while (0)
    bf16x8 qf[4];
    { const bf16* qp = U + (size_t)(qrow0 + rw * 32 + r32) * UW + U_DAQ + hh * 128 + mw * 64 + hi * 8;
#pragma unroll
      for (int d0 = 0; d0 < 4; ++d0) qf[d0] = *(const bf16x8*)(qp + d0 * 16); }
    DA_ISSUE(kt0, 0, 0); DA_ISSUE(kt0 + 1, 1, 1); DA_ISSUE(kt0 + 2, 2, 2);
    f32x16 o[4];
#pragma unroll
    for (int d = 0; d < 4; ++d) o[d] = f32x16{};
    f32x16 negm = f32x16{};
    float lsum = 0.f;
    const int kfo = mw * 8192 + (r32 >> 4) * 1024 + (r32 & 15) * 64;
    const int ksw = (r32 >> 2) & 3;
    const int vfo = VBASE + (4 * hi + ((lane & 15) >> 2)) * 64 + ((lane >> 4) & 1) * 32 + (lane & 3) * 8;
#define DA_KFR(KF, KSL) do { const lds_cptr kb_ = L3 + (KSL) * KSLOT + kfo; \
        _Pragma("unroll") for (int d0 = 0; d0 < 4; ++d0) { const int co_ = (d0 >> 1) * 4096 + ((((2 * d0 + hi) & 3) ^ ksw) * 16); \
            KF[2 * d0] = *(const __attribute__((address_space(3))) bf16x8*)(kb_ + co_); KF[2 * d0 + 1] = *(const __attribute__((address_space(3))) bf16x8*)(kb_ + co_ + 2048); } } while (0)
#define DA_QKM(P0, P1, KF) do { _Pragma("unroll") for (int d0 = 0; d0 < 4; ++d0) { \
            P0 = __builtin_amdgcn_mfma_f32_32x32x16_bf16(KF[2 * d0], qf[d0], d0 == 0 ? negm : P0, 0, 0, 0); \
            P1 = __builtin_amdgcn_mfma_f32_32x32x16_bf16(KF[2 * d0 + 1], qf[d0], d0 == 0 ? negm : P1, 0, 0, 0); } } while (0)
#define DA_MAX3(a, b, c) ({ float r_; asm("v_max3_f32 %0, %1, %2, %3" : "=v"(r_) : "v"(a), "v"(b), "v"(c)); r_; })
#define DA_VFRAG(VB, D, S2) ({ const s16x4 lo_ = __builtin_bit_cast(s16x4, __builtin_amdgcn_ds_read_tr16_b64_v4i16((__attribute__((address_space(3))) v4i16_t*)((VB) + ((D) * 4 + (S2)) * 1024))); \
        const s16x4 hv_ = __builtin_bit_cast(s16x4, __builtin_amdgcn_ds_read_tr16_b64_v4i16((__attribute__((address_space(3))) v4i16_t*)((VB) + ((D) * 4 + (S2)) * 1024 + 512))); \
        (bf16x8){lo_[0], lo_[1], lo_[2], lo_[3], hv_[0], hv_[1], hv_[2], hv_[3]}; })
#define DA_PACK(PF, P0, P1) do { _Pragma("unroll") for (int s2 = 0; s2 < 2; ++s2) { u32x4 w0_, w1_; \
            w0_.x = cvtpk(P0[8 * s2 + 0], P0[8 * s2 + 1]); w0_.y = cvtpk(P0[8 * s2 + 2], P0[8 * s2 + 3]); w0_.z = cvtpk(P0[8 * s2 + 4], P0[8 * s2 + 5]); w0_.w = cvtpk(P0[8 * s2 + 6], P0[8 * s2 + 7]); \
            w1_.x = cvtpk(P1[8 * s2 + 0], P1[8 * s2 + 1]); w1_.y = cvtpk(P1[8 * s2 + 2], P1[8 * s2 + 3]); w1_.z = cvtpk(P1[8 * s2 + 4], P1[8 * s2 + 5]); w1_.w = cvtpk(P1[8 * s2 + 6], P1[8 * s2 + 7]); \
            PF[s2] = __builtin_bit_cast(bf16x8, w0_); PF[2 + s2] = __builtin_bit_cast(bf16x8, w1_); } } while (0)
#define DA_SBAR() __builtin_amdgcn_sched_barrier(0)
#define DA_LA 2
#define DA_PIN(x) asm volatile("" : "+v"(x))
#define DA_FADD(a, b) ({ float r_; asm("v_add_f32 %0, %1, %2" : "=v"(r_) : "v"(a), "v"(b)); r_; })
#define DA_PEL(A, B, e) (((e) < 16) ? A[(e) & 15] : B[(e) & 15])
#define DA_TR(p) __builtin_bit_cast(s16x4, __builtin_amdgcn_ds_read_tr16_b64_v4i16((__attribute__((address_space(3))) v4i16_t*)(p)))
#define DA_VOFF(i) ((((i) & 3) * 4 + ((i) >> 2)) * 1024)
#define DA_KLD(kb, j) (*(const __attribute__((address_space(3))) bf16x8*)((kb) + (((j) & 2) ? kfoB : kfoA) + ((j) >> 2) * 4096 + ((j) & 1) * 2048))
#define DA_MFMA(a, b, c) __builtin_amdgcn_mfma_f32_32x32x16_bf16(a, b, c, 0, 0, 0)
#define DA_KLD2(ka, kb, j) (*(const __attribute__((address_space(3))) bf16x8*)((((j) & 2) ? (kb) : (ka)) + ((j) >> 2) * 4096 + ((j) & 1) * 2048))
    const int kfoA = kfo + ((hi ^ ksw) * 16), kfoB = kfo + (((2 + hi) ^ ksw) * 16);
    f32x16 pA0, pA1, pB0, pB1;
    bf16x8 kf[8];
    DA_WAIT_BAR(8);
#pragma unroll
    for (int j = 0; j < 8; ++j) kf[j] = DA_KLD(L3, j);
#pragma unroll
    for (int g = 0; g < 8; ++g) { if (g & 1) pA1 = DA_MFMA(kf[g], qf[g >> 1], (g == 1) ? negm : pA1); else pA0 = DA_MFMA(kf[g], qf[g >> 1], (g == 0) ? negm : pA0); }
    DA_WAIT_BAR(4);
    DA_ISSUE(kt0 + 3, 3, 3);
    kf[0] = DA_KLD(L3 + KSLOT, 0); kf[1] = DA_KLD(L3 + KSLOT, 1);
    { float rm = __builtin_fmaxf(pA0[0], pA1[0]);
#pragma unroll
      for (int r = 1; r < 16; ++r) rm = __builtin_fmaxf(rm, __builtin_fmaxf(pA0[r], pA1[r]));
      rm = swapmax(rm);
#pragma unroll
      for (int r = 0; r < 16; ++r) { negm[r] = -rm; pA0[r] = __builtin_amdgcn_exp2f(pA0[r] - rm); pA1[r] = __builtin_amdgcn_exp2f(pA1[r] - rm); } }
    int vprev = 0;
#define DA_PVM(i) o[(i) & 3] = DA_MFMA(((bf16x8){vlo_[(i) % DA_LA][0], vlo_[(i) % DA_LA][1], vlo_[(i) % DA_LA][2], vlo_[(i) % DA_LA][3], vhi_[(i) % DA_LA][0], vhi_[(i) % DA_LA][1], vhi_[(i) % DA_LA][2], vhi_[(i) % DA_LA][3]}), __builtin_bit_cast(bf16x8, pw_[(i) >> 2]), o[(i) & 3])
#define DA_VRD(i) do { if ((i) < 16) { vlo_[(i) % DA_LA] = DA_TR(vb_ + DA_VOFF((i) & 15)); vhi_[(i) % DA_LA] = DA_TR(vb_ + DA_VOFF((i) & 15) + 512); } } while (0)
#define DA_KRD(KREAD, j) do { if (KREAD) kf[(j) & 7] = DA_KLD2(kan_, kan_, (j) & 7); } while (0)
#define DA_STEP(C0, C1, P0, P1, TT, ISSUE, WAITSTMT, KREAD, BP, DP) do { \
        const int t_ = (TT); unsigned vbu_ = lds0 + vfo + vprev * VSLOT, kau_ = lds0 + kfoA + (t_ & 3) * KSLOT; \
        DA_PIN(vbu_); DA_PIN(kau_); unsigned kbu_ = kau_ ^ 32u; DA_PIN(kbu_);                     \
        const lds_cptr vb_ = (lds_cptr)(uintptr_t)(vbu_), ka_ = (lds_cptr)(uintptr_t)(kau_), kbb_ = (lds_cptr)(uintptr_t)(kbu_); \
        s16x4 vlo_[DA_LA], vhi_[DA_LA]; u32x4 pw_[4]; float sa1_ = 0.f; \
        DA_SBAR(); \
        _Pragma("unroll") for (int g = 0; g < 8; ++g) { \
            if (g & 1) C1 = DA_MFMA(kf[g], qf[g >> 1], (g == 1) ? negm : C1); else C0 = DA_MFMA(kf[g], qf[g >> 1], (g == 0) ? negm : C0); \
            if (g < 6) kf[(g + 2) & 7] = DA_KLD2(ka_, kbb_, (g + 2) & 7);                          \
            if (g >= 8 - DA_LA) DA_VRD(g - (8 - DA_LA)); \
            if (g == 0) { lsum = DA_FADD(lsum, DA_PEL(P0, P1, 0)); sa1_ = DA_FADD(DA_PEL(P0, P1, 1), DA_PEL(P0, P1, 3)); lsum = DA_FADD(lsum, DA_PEL(P0, P1, 2)); } \
            else { lsum = DA_FADD(lsum, DA_PEL(P0, P1, 4 * g)); sa1_ = DA_FADD(sa1_, DA_PEL(P0, P1, 4 * g + 1)); lsum = DA_FADD(lsum, DA_PEL(P0, P1, 4 * g + 2)); sa1_ = DA_FADD(sa1_, DA_PEL(P0, P1, 4 * g + 3)); } \
            pw_[g >> 1][(g & 1) * 2] = cvtpk(DA_PEL(P0, P1, 4 * g), DA_PEL(P0, P1, 4 * g + 1)); pw_[g >> 1][(g & 1) * 2 + 1] = cvtpk(DA_PEL(P0, P1, 4 * g + 2), DA_PEL(P0, P1, 4 * g + 3)); \
            DA_PIN(pw_[g >> 1]); DA_PIN(lsum); DA_PIN(sa1_); DA_SBAR(); } \
        lsum += sa1_; \
        if ((BP) == 0) { WAITSTMT; } \
          \
        DA_PVM(0); if ((ISSUE) && (DP) == 0) DA_ISSUE(kt0 + t_ + 3, (t_ + 3) & 3, (vprev == 0) ? 4 : vprev - 1); DA_VRD(DA_LA); DA_SBAR(); \
        DA_PVM(1); DA_VRD(1 + DA_LA); float rm_ = __builtin_fmaxf(C0[0], C1[0]); float rm2_ = DA_MAX3(C0[1], C1[1], C0[2]); rm_ = DA_MAX3(rm_, C1[2], C0[3]); rm2_ = DA_MAX3(rm2_, C0[4], C1[4]); rm_ = DA_MAX3(rm_, C0[5], C1[5]); \
        DA_PIN(rm_); DA_PIN(rm2_); DA_SBAR(); \
        DA_PVM(2); DA_VRD(2 + DA_LA); \
        _Pragma("unroll") for (int r = 6; r < 12; r += 2) { rm2_ = DA_MAX3(rm2_, C0[r], C1[r]); rm_ = DA_MAX3(rm_, C0[r + 1], C1[r + 1]); } \
        DA_PIN(rm_); DA_PIN(rm2_); DA_SBAR(); \
        DA_PVM(3); DA_VRD(3 + DA_LA); \
        _Pragma("unroll") for (int r = 12; r < 16; r += 2) { rm2_ = DA_MAX3(rm2_, C0[r], C1[r]); rm_ = DA_MAX3(rm_, C0[r + 1], C1[r + 1]); } \
        rm_ = DA_MAX3(rm_, rm2_, C1[3]); rm_ = swapmax(rm_); DA_PIN(rm_); DA_SBAR(); \
        bool resc_ = false; float fp_ = 1.f; \
        if (__any(rm_ > (float)THR)) { const float dl_ = fmaxf(rm_, 0.f), nm_ = negm[0] - dl_; fp_ = __builtin_amdgcn_exp2f(-dl_); lsum *= fp_; resc_ = true; \
            _Pragma("unroll") for (int r = 0; r < 16; ++r) { C0[r] -= dl_; C1[r] -= dl_; negm[r] = nm_; } } \
        unsigned kanu_ = lds0 + kfoA + ((t_ + 1) & 3) * KSLOT; DA_PIN(kanu_); const lds_cptr kan_ = (lds_cptr)(uintptr_t)(kanu_); \
        DA_SBAR(); \
        _Pragma("unroll") for (int i = 4; i < 16; ++i) { \
            if ((BP) == i) { WAITSTMT; }                                                             \
            DA_PVM(i); DA_VRD(i + DA_LA); if ((ISSUE) && (DP) == i) DA_ISSUE(kt0 + t_ + 3, (t_ + 3) & 3, (vprev == 0) ? 4 : vprev - 1); \
            if (i >= 14) DA_KRD(KREAD, i - 14); \
            _Pragma("unroll") for (int k = 0; k < ((i < 12) ? 3 : 2); ++k) { const int e = ((i < 12) ? (i - 4) * 3 : 24 + (i - 12) * 2) + k; \
                if (e < 16) C0[e & 15] = __builtin_amdgcn_exp2f(C0[e & 15]); else C1[e & 15] = __builtin_amdgcn_exp2f(C1[e & 15]); } \
            DA_PIN(C0); DA_PIN(C1); DA_SBAR(); } \
        if (resc_) { _Pragma("unroll") for (int d = 0; d < 4; ++d) _Pragma("unroll") for (int r = 0; r < 16; ++r) o[d][r] *= fp_; } \
        vprev = (vprev == 4) ? 0 : vprev + 1; \
    } while (0)
    int t = 1;
    constexpr int BP_ = (MW == 0) ? 0 : 8, DP_ = (MW == 0) ? 0 : 12;
    for (; t + 4 < NT; t += 2) {
        DA_STEP(pB0, pB1, pA0, pA1, t, true, DA_WAIT_BAR(4), true, BP_, DP_);
        DA_STEP(pA0, pA1, pB0, pB1, t + 1, true, DA_WAIT_BAR(4), true, BP_, DP_);
    }
    DA_STEP(pB0, pB1, pA0, pA1, t, false, DA_WAIT_BAR(4), true, BP_, DP_);
    DA_STEP(pA0, pA1, pB0, pB1, t + 1, false, DA_WAIT_BAR(0), true, BP_, DP_);
    DA_STEP(pB0, pB1, pA0, pA1, t + 2, false, DA_WAIT_BAR(0), false, BP_, DP_);
    { float sa = 0.f;
#pragma unroll
      for (int r = 0; r < 16; ++r) sa += pB0[r] + pB1[r];
      lsum += sa;
      bf16x8 pfp[4];
#pragma unroll
      for (int s2 = 0; s2 < 2; ++s2) { u32x4 w0_, w1_;
          w0_.x = cvtpk(pB0[8 * s2 + 0], pB0[8 * s2 + 1]); w0_.y = cvtpk(pB0[8 * s2 + 2], pB0[8 * s2 + 3]); w0_.z = cvtpk(pB0[8 * s2 + 4], pB0[8 * s2 + 5]); w0_.w = cvtpk(pB0[8 * s2 + 6], pB0[8 * s2 + 7]);
          w1_.x = cvtpk(pB1[8 * s2 + 0], pB1[8 * s2 + 1]); w1_.y = cvtpk(pB1[8 * s2 + 2], pB1[8 * s2 + 3]); w1_.z = cvtpk(pB1[8 * s2 + 4], pB1[8 * s2 + 5]); w1_.w = cvtpk(pB1[8 * s2 + 6], pB1[8 * s2 + 7]);
          pfp[s2] = __builtin_bit_cast(bf16x8, w0_); pfp[2 + s2] = __builtin_bit_cast(bf16x8, w1_); }
      unsigned vbu = lds0 + vfo + vprev * VSLOT; DA_PIN(vbu);
      const lds_cptr vb = (lds_cptr)(uintptr_t)(vbu);
#pragma unroll
      for (int s2 = 0; s2 < 4; ++s2)
#pragma unroll
          for (int d = 0; d < 4; ++d) o[d] = __builtin_amdgcn_mfma_f32_32x32x16_bf16(DA_VFRAG(vb, d, s2), pfp[s2], o[d], 0, 0, 0); }
#undef DA_STEP
#undef DA_PVM
#undef DA_VRD
#undef DA_KRD
#undef DA_SBAR
#undef DA_LA
#undef DA_PIN
#undef DA_FADD
#undef DA_PEL
#undef DA_TR
#undef DA_VOFF
#undef DA_KLD
#undef DA_KLD2
#undef DA_MFMA
#undef DA_KFR
#undef DA_QKM
#undef DA_MAX3
#undef DA_VFRAG
#undef DA_PACK
    __builtin_amdgcn_s_setprio(0);
    {
        int lane_e = F.lane; asm volatile("" : "+v"(lane_e));
        const int lane = lane_e, r32 = lane & 31, hi = lane >> 5;
        const float lam = WSP(float, WS_LAM)[l]; const float lam_init = 0.8f - 0.6f * __expf(-0.3f * (float)l);
        const float inv = ((mw == 0) ? 1.f : lam) / swapadd(lsum);
        asm volatile("s_waitcnt lgkmcnt(0)\n\ts_barrier" ::: "memory");
        float* X = (float*)F.lds + rw * 4096 + lane;
        if (mw == 1) {
#pragma unroll
            for (int d = 0; d < 4; ++d)
#pragma unroll
                for (int r = 0; r < 16; ++r) X[(d * 16 + r) * 64] = o[d][r] * inv;
        }
        asm volatile("s_waitcnt lgkmcnt(0)\n\ts_barrier" ::: "memory");
        if (mw == 0) {
            float ss = 0.f;
#pragma unroll
            for (int d = 0; d < 4; ++d)
#pragma unroll
                for (int r = 0; r < 16; ++r) { const float v = o[d][r] * inv - X[(d * 16 + r) * 64]; o[d][r] = v; ss += v * v; }
            ss = swapadd(ss);
            const float rstd = rsqrtf(ss * (1.f / 128.f) + EPS) * (1.f - lam_init);
            const float* sw = F.p->in[I_SUBLN] + l * 128;
            bf16* orow = MIX + (size_t)(qrow0 + rw * 32 + r32) * DM + 512 + hh * 128;
            f32x4 swv[4][4];
#pragma unroll
            for (int d = 0; d < 4; ++d)
#pragma unroll
                for (int g = 0; g < 4; ++g) swv[d][g] = *(const f32x4*)(sw + d * 32 + 8 * g + 4 * hi);
            __builtin_amdgcn_sched_barrier(0);
#pragma unroll
            for (int d = 0; d < 4; ++d)
#pragma unroll
                for (int g = 0; g < 4; ++g) { const int dd = d * 32 + 8 * g + 4 * hi; const f32x4 w = swv[d][g];
                    u32x2 ov; ov.x = cvtpk(o[d][4 * g] * rstd * w.x, o[d][4 * g + 1] * rstd * w.y); ov.y = cvtpk(o[d][4 * g + 2] * rstd * w.z, o[d][4 * g + 3] * rstd * w.w);
                    *(u32x2*)(orow + dd) = ov; }
        }
    }
    asm volatile("s_waitcnt lgkmcnt(0)\n\ts_barrier" ::: "memory");
#undef DA_KROW
#undef DA_ISSUE
}
__device__ __forceinline__ void unit(Frame& F, int l, int b, int hh, long qrow0, int kt0, int NT) {
    if (F.wave < 4) unit_t<0>(F, l, b, hh, qrow0, kt0, NT); else unit_t<1>(F, l, b, hh, qrow0, kt0, NT);
}
#undef DA_WAIT_BAR
}
__device__ __forceinline__ void ph_attn_fast(Frame& F, int l) {
    const int vcu = (F.G % 8 == 0) ? (F.bid % 8) * (F.G / 8) + F.bid / 8 : F.bid;
    const int nu = 1024 + ((l == 0) ? 64 : 0);
    for (int u = vcu; u < nu; u += F.G) {
        if (u < 1024) { const int bh = u >> 5, qb = u & 31, b = bh >> 2, hh = bh & 3; da::unit(F, l, b, hh, (long)b * SEQ + qb * 128, 0, 68); }
        else { const int r = u - 1024, bh = r >> 1, b = bh >> 2, hh = bh & 3; da::unit(F, l, b, hh, (long)NLAT + (long)b * CTXL + (r & 1) * 128, 64, 4); }
    }
}

__device__ __forceinline__ void ph_mixers_naive(Frame& F, int l) {
    if (FAST_HYENA) { for (int rep = 0; rep < DUP(1); ++rep) for (int c = F.bid; c < 256; c += F.G) hy::unit(F, l, c); }
    else for (int it = F.bid; it < 2048; it += F.G) hy_naive_item(F, l, it >> 3, it & 7, SEQ, WSP(float, WS_H2L) + (size_t)l * 4096 * 64, WSP(bf16, WS_HYV), WSP(bf16, WS_HYX1), WSP(bf16, WS_HYX2), WSP(bf16, WS_HYY));
    if (l == 0) for (int rep = 0; rep < DUP(2); ++rep) for (int it = F.bid; it < 2048; it += F.G) hy_naive_item(F, l, it >> 3, it & 7, CTXL, WSP(float, WS_H2C), WSP(bf16, WS_HYVC), WSP(bf16, WS_HYX1C), WSP(bf16, WS_HYX2C), WSP(bf16, WS_HYYC));
    if (FAST_MLSTM) { for (int sq = F.bid; sq < 64; sq += F.G) ml::s2_item(F, sq, F.wave); }
    else for (int it = F.bid; it < 64; it += F.G) ml_naive_item(F, it >> 3, (it >> 1) & 3, it & 1);
    if (FAST_ATTN) { for (int rep = 0; rep < DUP(0); ++rep) ph_attn_fast(F, l); return; }
    for (int it = F.bid; it < 2048; it += F.G) { const int b = it >> 8, hh = (it >> 6) & 3, qb = it & 63; da_naive_item(F, l, b, hh, (long)b * SEQ + qb * 64, 0, 68); }
    if (l == 0) for (int it = F.bid; it < 128; it += F.G) { const int b = it >> 4, hh = (it >> 2) & 3, qb = it & 3; da_naive_item(F, l, b, hh, NLAT + (long)b * CTXL + qb * 64, 64, 68); }
}

__device__ __forceinline__ void hyc_unit(Frame& F, int c) {
    const CAS Params& P = *F.p;
    float* T = (float*)F.lds;
    float* z = T + 512;
    float* red = z + 2048;
    const bf16* V = WSP(bf16, WS_HYVC) + (size_t)c * 8 * CTXL; const bf16* X1 = WSP(bf16, WS_HYX1C) + (size_t)c * 8 * CTXL; const bf16* X2 = WSP(bf16, WS_HYX2C) + (size_t)c * 8 * CTXL; bf16* Y = WSP(bf16, WS_HYYC) + (size_t)c * 8 * CTXL;
    for (int i = F.tid; i < 2048; i += NTHREADS) z[i] = bf2f(V[i]);
    const int b = F.tid >> 6, tl = F.tid & 63;
    for (int o = 0; o < 2; ++o) {
        hy_taps(F, 0, o, c, CTXL, WSP(float, WS_H2C), T, red);
        const float dd = P.in[I_HBD][o * 256 + c]; const bf16* G = (o == 0) ? X1 : X2;
        float res[4] = {0.f, 0.f, 0.f, 0.f};
        for (int sI = 0; sI < CTXL; ++sI) { const float zs = z[b * CTXL + sI];
#pragma unroll
            for (int q = 0; q < 4; ++q) res[q] += T[tl + 64 * q - sI + CTXL] * zs; }
#pragma unroll
        for (int q = 0; q < 4; ++q) { const int t = tl + 64 * q; res[q] = bf2f(G[b * CTXL + t]) * (res[q] + dd * z[b * CTXL + t]); }
        __syncthreads();
#pragma unroll
        for (int q = 0; q < 4; ++q) { const int t = tl + 64 * q; if (o == 0) z[b * CTXL + t] = bf2f(f2bf(res[q])); else Y[b * CTXL + t] = f2bf(res[q]); }
        __syncthreads();
    }
}
__device__ __forceinline__ void conv_moe_item(Frame& F, int l, int k) {
    float* scr = (float*)(F.lds) + F.wave * (64 * 33);
    const float* w1 = F.p->in[I_W1] + (size_t)l * NEXP * DM * FF; const float* w3 = F.p->in[I_W3] + (size_t)l * NEXP * DM * FF; const float* w2 = F.p->in[I_W2] + (size_t)l * NEXP * FF * DM;
    bf16* UPT = WSP(bf16, WS_UPT); bf16* DNT = WSP(bf16, WS_DNT);
    const int it = k * 8 + F.wave;
    const int which = it / 8192, r = it % 8192, e = r / 256, q = r % 256;
    if (which < 2) { const int kb = q / 16, nb = q % 16, n0 = nb * 32, rd = (n0 >> 7) * 256 + (n0 & 127) + which * 128;
        tr_item((which ? w3 : w1) + (size_t)e * DM * FF, FF, kb * 64, n0, 32, UPT + (size_t)e * 1024 * 1024, 1024, rd, scr, F.lane); }
    else { const int kb = q / 32, nb = q % 32;
        tr_item(w2 + (size_t)e * FF * DM, DM, kb * 64, nb * 32, 32, DNT + (size_t)e * 1024 * 512, 512, nb * 32, scr, F.lane); }
    __syncthreads();
}
struct TrP { const float* src; int ldw; bf16* dst; int ldt; };
__device__ __forceinline__ TrP conv_decode(Frame& F, int l, int k) {
    const float* w1 = F.p->in[I_W1] + (size_t)l * NEXP * DM * FF; const float* w3 = F.p->in[I_W3] + (size_t)l * NEXP * DM * FF; const float* w2 = F.p->in[I_W2] + (size_t)l * NEXP * FF * DM;
    bf16* UPT = WSP(bf16, WS_UPT); bf16* DNT = WSP(bf16, WS_DNT);
    const int it = k * 8 + F.wave; const int which = it / 8192, r = it % 8192, e = r / 256, q = r % 256; TrP t;
    if (which < 2) { const int kb = q / 16, nb = q % 16, n0 = nb * 32, rd = (n0 >> 7) * 256 + (n0 & 127) + which * 128;
        t.src = (which ? w3 : w1) + (size_t)e * DM * FF + (size_t)(kb * 64) * FF + n0; t.ldw = FF; t.dst = UPT + (size_t)e * 1024 * 1024 + (size_t)rd * 1024 + kb * 64; t.ldt = 1024; }
    else { const int kb = q / 32, nb = q % 32; t.src = w2 + (size_t)e * FF * DM + (size_t)(kb * 64) * DM + nb * 32; t.ldw = DM; t.dst = DNT + (size_t)e * 1024 * 512 + (size_t)(nb * 32) * 512 + kb * 64; t.ldt = 512; }
    return t;
}
__device__ __forceinline__ void conv_moe_quad(Frame& F, int l, int k4) {
    float* scr = (float*)(F.lds) + F.wave * (64 * 33);
    const int lane = F.lane, kr = lane >> 3, c4 = (lane & 7) * 4, c = lane & 7;
    TrP p = conv_decode(F, l, k4);
    f32x4 v[8];
#pragma unroll
    for (int i = 0; i < 8; ++i) v[i] = *(const f32x4*)(p.src + (size_t)(8 * i + kr) * p.ldw + c4);
#pragma unroll 1
    for (int j = 0; j < 4; ++j) {
#pragma unroll
        for (int i = 0; i < 8; ++i) { float* d = scr + (8 * i + kr) * 33 + c4; d[0] = v[i].x; d[1] = v[i].y; d[2] = v[i].z; d[3] = v[i].w; }
        asm volatile("s_waitcnt lgkmcnt(0)" ::: "memory");
        const TrP pn = conv_decode(F, l, k4 + ((j < 3) ? j + 1 : j));
        if (j < 3) {
#pragma unroll
            for (int i = 0; i < 8; ++i) v[i] = *(const f32x4*)(pn.src + (size_t)(8 * i + kr) * pn.ldw + c4); }
        __builtin_amdgcn_sched_barrier(0);
#pragma unroll
        for (int j4 = 0; j4 < 4; ++j4) { const int n = (lane >> 3) + 8 * j4; const float* sp = scr + (8 * c) * 33 + n;
            u32x4 o; o.x = pk2(sp[0 * 33], sp[1 * 33]); o.y = pk2(sp[2 * 33], sp[3 * 33]); o.z = pk2(sp[4 * 33], sp[5 * 33]); o.w = pk2(sp[6 * 33], sp[7 * 33]);
            *(u32x4*)(p.dst + (size_t)n * p.ldt + 8 * c) = o; }
        asm volatile("s_waitcnt lgkmcnt(0)" ::: "memory");
        p = pn;
    }
    __syncthreads();
}
template <int PW = 0, bool RAW = false>
__device__ __forceinline__ int q_pull(Frame& F, unsigned* heads, int ty, int nper, int myx, int& qoff) {
    volatile int* slotw = (volatile int*)(F.lds + LDS_CTL_OFF + 64);
    if (F.wave == PW) {
        int res = -1;
        unsigned own = 0u; if (F.lane == 0) own = __hip_atomic_fetch_add(heads + (ty * 8 + myx) * 64, 1u, __ATOMIC_RELAXED, __HIP_MEMORY_SCOPE_AGENT);
        for (int tries = 0; tries < 64; ++tries) {
            const int q = (myx + (F.lane & 7)) & 7;
            const unsigned h = __hip_atomic_load(heads + (ty * 8 + q) * 64, __ATOMIC_RELAXED, __HIP_MEMORY_SCOPE_AGENT);
            if (tries == 0) { const int o_ = __builtin_amdgcn_readfirstlane((int)own); if (o_ >= 0 && o_ < nper) { res = myx * 65536 + o_; break; } }
            const unsigned long long live = __ballot(F.lane < 8 && (int)h < nper);
            if (live == 0ull) break;
            const int pick = __builtin_ctzll(live);
            const int qp = (myx + pick) & 7;
            unsigned idx = 0u;
            if (F.lane == 0) idx = __hip_atomic_fetch_add(heads + (ty * 8 + qp) * 64, 1u, __ATOMIC_RELAXED, __HIP_MEMORY_SCOPE_AGENT);
            idx = (unsigned)__builtin_amdgcn_readfirstlane((int)idx);
            if ((int)idx < nper) { res = qp * 65536 + (int)idx; break; }
        }
        if (F.lane == 0) { slotw[0] = res; slotw[1] = qoff; }
    }
    if (RAW) asm volatile("s_waitcnt lgkmcnt(0)\n\ts_barrier" ::: "memory"); else __syncthreads();
    const int res = slotw[0];
    if (RAW) asm volatile("s_waitcnt lgkmcnt(0)\n\ts_barrier" ::: "memory"); else __syncthreads();
    return res;
}
__device__ __forceinline__ void ph_mixers_dyn(Frame& F0, int l, unsigned char* lds) {
    Frame F = F0; const int g_wave0 = F0.wave;
#define mkframe(L) mkframe_(L, g_wave0)
    unsigned* heads = WSP(unsigned, WS_CTL) + CW_Q + l * 4096;
    const int myx = (int)(xb_xcc_id() & 7u);
    const bool convfirst = ((F.bid >> 3) & 1) == 0;
#define MIX_CONV_BURST(NP) do { int qoff_ = 0; for (int np_ = 0; np_ < (NP); ++np_) { const int r = q_pull(F, heads, 5, 96, myx, qoff_); if (r < 0) break; const int k4 = ((r >> 16) * 96 + (r & 65535)) * 4; \
            conv_moe_quad(F, l, k4); } } while (0)
    if (convfirst) { bool s2_ = false; { int qoff = 0; const int r = q_pull(F, heads, 0, 8, myx, qoff); if (r >= 0) { ml::s2_item(F, (r >> 16) * 8 + (r & 65535), F.wave); s2_ = true; } } F = mkframe(lds); MIX_CONV_BURST(s2_ ? 2 : 3); F = mkframe(lds); }
    { int qoff = 0; for (;;) { const int r = q_pull(F, heads, 1, 32, myx, qoff); if (r < 0) break; hy::unit(F, l, (r >> 16) * 32 + (r & 65535)); } }
    F = mkframe(lds);
    if (!convfirst) { bool s2_ = false; { int qoff = 0; const int r = q_pull(F, heads, 0, 8, myx, qoff); if (r >= 0) { ml::s2_item(F, (r >> 16) * 8 + (r & 65535), F.wave); s2_ = true; } } F = mkframe(lds); MIX_CONV_BURST(s2_ ? 2 : 3); F = mkframe(lds); }
    { int qoff = 0; for (;;) { const int r = q_pull<4, true>(F, heads, 2, 128, myx, qoff); if (r < 0) break; const int x = r >> 16, j = r & 65535, bh = x + 8 * (j >> 5), qb = j & 31, b = bh >> 2, hh = bh & 3;
          da::unit(F, l, b, hh, (long)b * SEQ + qb * 128, 0, 68); } }
    if (l == 0) {
        F = mkframe(lds);
        { int qoff = 0; for (;;) { const int r = q_pull(F, heads, 3, 8, myx, qoff); if (r < 0) break; const int rr = (r >> 16) * 8 + (r & 65535), bh = rr >> 1, b = bh >> 2, hh = bh & 3;
              da::unit(F, l, b, hh, (long)NLAT + (long)b * CTXL + (rr & 1) * 128, 64, 4); } }
        F = mkframe(lds);
        { int qoff = 0; for (;;) { const int r = q_pull(F, heads, 4, 32, myx, qoff); if (r < 0) break; hyc_unit(F, (r >> 16) * 32 + (r & 65535)); } }
    }
    F = mkframe(lds);
    { int qoff = 0; for (;;) { const int r = q_pull(F, heads, 0, 8, myx, qoff); if (r < 0) break; ml::s2_item(F, (r >> 16) * 8 + (r & 65535), F.wave); } }
    F = mkframe(lds);
    { int qoff = 0; for (;;) { const int r = q_pull(F, heads, 5, 96, myx, qoff); if (r < 0) break; const int k4 = ((r >> 16) * 96 + (r & 65535)) * 4;
          conv_moe_quad(F, l, k4); } }
#undef MIX_CONV_BURST
#undef mkframe
}

__device__ __forceinline__ void ph_assemble(Frame& F, int l) {
    const CAS Params& P = *F.p;
    bf16* MIX = WSP(bf16, WS_HB);
    bf16* S = (bf16*)F.lds;
    const int nitems = 8 * 64 * 4 + ((l == 0) ? 8 * 4 * 4 : 0);
    for (int it0 = F.bid; it0 < nitems; it0 += 4 * F.G) {
#pragma unroll
        for (int q4 = 0; q4 < 4; ++q4) { const int it = it0 + q4 * F.G;
            if (it < nitems) { int seq, tb, cbk, Ls; const bf16* Y;
                if (it < 2048) { seq = it >> 8; tb = (it >> 2) & 63; cbk = it & 3; Ls = SEQ; Y = WSP(bf16, WS_HYY); }
                else { const int r = it - 2048; seq = r >> 4; tb = (r >> 2) & 3; cbk = r & 3; Ls = CTXL; Y = WSP(bf16, WS_HYYC); }
                const int c = F.tid >> 3, tq = (F.tid & 7) * 8;
                *(u32x4*)(S + q4 * (64 * 72) + c * 72 + tq) = *(const u32x4*)(Y + ((size_t)(cbk * 64 + c) * 8 + seq) * Ls + tb * 64 + tq); } }
        __syncthreads();
#pragma unroll
        for (int q4 = 0; q4 < 4; ++q4) { const int it = it0 + q4 * F.G;
            if (it < nitems) { int seq, tb, cbk; long rbase;
                if (it < 2048) { seq = it >> 8; tb = (it >> 2) & 63; cbk = it & 3; rbase = (long)seq * SEQ; }
                else { const int r = it - 2048; seq = r >> 4; tb = (r >> 2) & 3; cbk = r & 3; rbase = NLAT + (long)seq * CTXL; }
                const int t = F.tid >> 3, cq = (F.tid & 7) * 8; unsigned short v[8];
#pragma unroll
                for (int q = 0; q < 8; ++q) v[q] = S[q4 * (64 * 72) + (cq + q) * 72 + t];
                u32x4 ov; ov.x = v[0] | ((unsigned)v[1] << 16); ov.y = v[2] | ((unsigned)v[3] << 16); ov.z = v[4] | ((unsigned)v[5] << 16); ov.w = v[6] | ((unsigned)v[7] << 16);
                *(u32x4*)(MIX + (size_t)(rbase + tb * 64 + t) * DM + cbk * 64 + cq) = ov; } }
        __syncthreads();
    }
    if (FAST_MLSTM) { __syncthreads(); ph_ml_s3(F, l); return; }
    const bf16* H0 = WSP(bf16, WS_MLH); const bf16* H1 = H0 + (size_t)MTOT * 256; const bf16* U = WSP(bf16, WS_U);
    const float* nw = P.in[I_MNW] + l * 256;
    const int gw = F.bid * NWAVES + F.wave, NGW = F.G * NWAVES;
    const int nrows = (l == 0) ? MTOT : NLAT;
    for (int row = gw; row < nrows; row += NGW) {
        const int c = 4 * F.lane;
        const u32x2 a = *(const u32x2*)(H0 + (size_t)row * 256 + c), b = *(const u32x2*)(H1 + (size_t)row * 256 + c), og = *(const u32x2*)(U + (size_t)row * UW + U_MLO + c);
        float h[4] = { __uint_as_float(a.x << 16) + __uint_as_float(b.x << 16), __uint_as_float(a.x & 0xffff0000u) + __uint_as_float(b.x & 0xffff0000u),
                       __uint_as_float(a.y << 16) + __uint_as_float(b.y << 16), __uint_as_float(a.y & 0xffff0000u) + __uint_as_float(b.y & 0xffff0000u) };
        const float ov[4] = { __uint_as_float(og.x << 16), __uint_as_float(og.x & 0xffff0000u), __uint_as_float(og.y << 16), __uint_as_float(og.y & 0xffff0000u) };
        float ss = h[0] * h[0] + h[1] * h[1] + h[2] * h[2] + h[3] * h[3];
        ss += __shfl_xor(ss, 1); ss += __shfl_xor(ss, 2); ss += __shfl_xor(ss, 4); ss += __shfl_xor(ss, 8);
        const float rstd = rsqrtf(ss * (1.f / 64.f) + EPS);
        float r[4];
#pragma unroll
        for (int q = 0; q < 4; ++q) r[q] = sigmoidf(ov[q]) * h[q] * rstd * nw[c + q];
        u32x2 o2; o2.x = pk2(r[0], r[1]); o2.y = pk2(r[2], r[3]);
        *(u32x2*)(MIX + (size_t)row * DM + 256 + c) = o2;
    }
}

template <bool DRY>
__device__ __forceinline__ void ph_norm2_router(Frame& F, int l) {
    const CAS Params& P = *F.p;
    float* Wr = (float*)F.lds;
    int* lcnt = (int*)(F.lds + 147456);
    int* rec = lcnt + 32;
    { const float* wg = P.in[I_WG] + (size_t)l * DM * 4; const float* we = P.in[I_WE] + (size_t)l * DM * 32;
#pragma unroll
      for (int q = 0; q < 2; ++q) { const int k = F.tid + q * NTHREADS; const f32x4 v = *(const f32x4*)(wg + 4 * k); Wr[k] = v.x; Wr[DM + k] = v.y; Wr[2 * DM + k] = v.z; Wr[3 * DM + k] = v.w; }
#pragma unroll 4
      for (int q = 0; q < 16; ++q) { const int i4 = F.tid + q * NTHREADS; const int k = i4 >> 3, n4 = (i4 & 7) * 4; const f32x4 v = *(const f32x4*)(we + 4 * i4);
          Wr[(4 + n4) * DM + k] = v.x; Wr[(5 + n4) * DM + k] = v.y; Wr[(6 + n4) * DM + k] = v.z; Wr[(7 + n4) * DM + k] = v.w; }
      if (F.tid < 32) lcnt[F.tid] = 0; }
    __syncthreads();
    const float* mods = WSP(float, WS_MODS); float* XC = WSP(float, WS_XC); bf16* HB = WSP(bf16, WS_HB);
    int* EXPID = WSP(int, WS_EXPID); float* GATEV = WSP(float, WS_GATEV); int* LIST = WSP(int, WS_LIST); unsigned* CNT = WSP(unsigned, WS_CTL) + CW_CNT + l * 32 * CNT_STRIDE;
    const float* bg = P.in[I_BG] + l * 4; const float* be = P.in[I_BE] + l * 32; const float* nw = P.in[I_N2W] + l * DM;
    const int gw = F.bid * NWAVES + F.wave, NGW = F.G * NWAVES;
    const int nrows = (l == 0) ? MTOT : NLAT;
    int kk = 0;
    f32x4 nwv[4];
#pragma unroll
    for (int j = 0; j < 4; ++j) nwv[j] = *(const f32x4*)(nw + 256 * j + 4 * F.lane);
    u32x2 xn[4];
    if (gw < nrows) { const bf16* X0 = xrow_ptr(P.out, F.ws, gw);
#pragma unroll
        for (int j = 0; j < 4; ++j) xn[j] = *(const u32x2*)(X0 + 256 * j + 4 * F.lane); }
    for (int row = gw; row < nrows; row += NGW, ++kk) {
        const int bsel = row < NLAT ? (row >> 12) : 8;
        const float* sh = mods + (size_t)(l * 9 + bsel) * 6144 + 3 * DM; const float* sc = sh + DM;
        u32x2 xc[4];
#pragma unroll
        for (int j = 0; j < 4; ++j) xc[j] = xn[j];
        if (row + NGW < nrows) { const bf16* X1 = xrow_ptr(P.out, F.ws, row + NGW);
#pragma unroll
            for (int j = 0; j < 4; ++j) xn[j] = *(const u32x2*)(X1 + 256 * j + 4 * F.lane); }
        f32x4 s1v[4], s0v[4];
#pragma unroll
        for (int j = 0; j < 4; ++j) { s1v[j] = *(const f32x4*)(sc + 256 * j + 4 * F.lane); s0v[j] = *(const f32x4*)(sh + 256 * j + 4 * F.lane); }
        f32x4 v[4]; float ss = 0.f;
#pragma unroll
        for (int j = 0; j < 4; ++j) { const u32x2 xv = xc[j]; v[j].x = __uint_as_float(xv.x << 16); v[j].y = __uint_as_float(xv.x & 0xffff0000u); v[j].z = __uint_as_float(xv.y << 16); v[j].w = __uint_as_float(xv.y & 0xffff0000u); ss += (v[j].x * v[j].x + v[j].y * v[j].y) + (v[j].z * v[j].z + v[j].w * v[j].w); }
        const float rstd = rsqrtf(wave_sum(ss) * (1.f / DM) + EPS);
#pragma unroll
        for (int j = 0; j < 4; ++j) { const int c = 256 * j + 4 * F.lane; const f32x4 w = nwv[j], s1 = s1v[j], s0 = s0v[j];
            v[j] = v[j] * rstd * w * (s1 + 1.f) + s0;
            u32x2 o; o.x = pk2(v[j].x, v[j].y); o.y = pk2(v[j].z, v[j].w); *(u32x2*)(HB + (size_t)row * DM + c) = o; }
        float g[4];
        { float a[4];
#pragma unroll
          for (int n = 0; n < 4; ++n) { a[n] = 0.f;
#pragma unroll
              for (int j = 0; j < 4; ++j) { const f32x4 w = *(const f32x4*)(Wr + n * DM + 256 * j + 4 * F.lane); a[n] += (v[j].x * w.x + v[j].y * w.y) + (v[j].z * w.z + v[j].w * w.w); } }
          { const bool up = (F.lane & 32) != 0;
#pragma unroll
            for (int i = 0; i < 2; ++i) { const float snd = up ? a[i] : a[i + 2]; const float rcv = __shfl_xor(snd, 32); a[i] = (up ? a[i + 2] : a[i]) + rcv; } }
          { const bool up = (F.lane & 16) != 0; const float snd = up ? a[0] : a[1]; const float rcv = __shfl_xor(snd, 16); a[0] = (up ? a[1] : a[0]) + rcv; }
#pragma unroll
          for (int o = 8; o >= 1; o >>= 1) a[0] += __shfl_xor(a[0], o);
#pragma unroll
          for (int n = 0; n < 4; ++n) g[n] = __shfl(a[0], n * 16) + bg[n]; }
        int gi = 0; float gm = g[0];
#pragma unroll
        for (int n = 1; n < 4; ++n) if (g[n] > gm) { gm = g[n]; gi = n; }
        float gs = 0.f;
#pragma unroll
        for (int n = 0; n < 4; ++n) gs += __expf(g[n] - gm);
        const float gwt = __builtin_amdgcn_rcpf(gs);
        float e[8];
        { float a[8]; const float* Wg = Wr + (4 + gi * 8) * DM;
#pragma unroll
          for (int n = 0; n < 8; ++n) { a[n] = 0.f;
#pragma unroll
              for (int j = 0; j < 4; ++j) { const f32x4 w = *(const f32x4*)(Wg + n * DM + 256 * j + 4 * F.lane); a[n] += (v[j].x * w.x + v[j].y * w.y) + (v[j].z * w.z + v[j].w * w.w); } }
          { const bool up = (F.lane & 32) != 0;
#pragma unroll
            for (int i = 0; i < 4; ++i) { const float snd = up ? a[i] : a[i + 4]; const float rcv = __shfl_xor(snd, 32); a[i] = (up ? a[i + 4] : a[i]) + rcv; } }
          { const bool up = (F.lane & 16) != 0;
#pragma unroll
            for (int i = 0; i < 2; ++i) { const float snd = up ? a[i] : a[i + 2]; const float rcv = __shfl_xor(snd, 16); a[i] = (up ? a[i + 2] : a[i]) + rcv; } }
          { const bool up = (F.lane & 8) != 0; const float snd = up ? a[0] : a[1]; const float rcv = __shfl_xor(snd, 8); a[0] = (up ? a[1] : a[0]) + rcv; }
#pragma unroll
          for (int o = 4; o >= 1; o >>= 1) a[0] += __shfl_xor(a[0], o);
#pragma unroll
          for (int n = 0; n < 8; ++n) e[n] = __shfl(a[0], n * 8) + be[gi * 8 + n]; }
        int i1 = 0; float v1 = e[0];
#pragma unroll
        for (int n = 1; n < 8; ++n) if (e[n] > v1) { v1 = e[n]; i1 = n; }
        int i2 = -1; float v2 = -INFINITY;
#pragma unroll
        for (int n = 0; n < 8; ++n) if (n != i1 && e[n] > v2) { v2 = e[n]; i2 = n; }
        if (i2 < 0) { i2 = (i1 == 0) ? 1 : 0; v2 = e[i1 == 0 ? 1 : 0]; }
        const float p2 = __expf(v2 - v1); const float ga = gwt * __builtin_amdgcn_rcpf(1.f + p2), gb = ga * p2;
        if (!DRY && F.lane == 0) {
            const int e1 = gi * 8 + i1, e2 = gi * 8 + i2;
            int* rc = rec + (F.wave * 18 + kk) * 4;
            rc[0] = e1; rc[1] = e2; rc[2] = atomicAdd(&lcnt[e1], 1); rc[3] = atomicAdd(&lcnt[e2], 1);
            EXPID[row * 2] = e1; EXPID[row * 2 + 1] = e2; GATEV[row * 2] = ga; GATEV[row * 2 + 1] = gb;
        }
    }
    if (!DRY) {
        __syncthreads();
        if (F.tid < 32) { const int c = lcnt[F.tid]; lcnt[F.tid] = (c > 0) ? (int)atomicAdd(&CNT[F.tid * CNT_STRIDE], (unsigned)c) : 0; }
        __syncthreads();
        if (F.lane == 0) { int k2 = 0;
            for (int row = gw; row < nrows; row += NGW, ++k2) { const int* rc = rec + (F.wave * 18 + k2) * 4;
                LIST[(size_t)rc[0] * MTOT + lcnt[rc[0]] + rc[2]] = row * 2; LIST[(size_t)rc[1] * MTOT + lcnt[rc[1]] + rc[3]] = row * 2 + 1; } }
    }
}

__device__ __forceinline__ void moe_offsets(const unsigned* CNT, int (&cnt)[32], int (&poff)[33]) {
    int acc = 0;
#pragma unroll
    for (int e = 0; e < 32; ++e) { cnt[e] = (int)__hip_atomic_load(CNT + e * CNT_STRIDE, __ATOMIC_RELAXED, __HIP_MEMORY_SCOPE_AGENT); poff[e] = acc; acc += ((cnt[e] + 255) >> 8) << 8; }
    poff[32] = acc;
}
__device__ __forceinline__ void ph_moe_up_naive(Frame& F, int l) {
    const bf16* HB = WSP(bf16, WS_HB); const bf16* UPT = WSP(bf16, WS_UPT); bf16* HBUF = WSP(bf16, WS_HBUF); const int* LIST = WSP(int, WS_LIST);
    const unsigned* CNT = WSP(unsigned, WS_CTL) + CW_CNT + l * 32 * CNT_STRIDE;
    int* tab = (int*)(F.lds + 64 * 1024);
    if (F.tid == 0) { int cnt[32], poff[33]; moe_offsets(CNT, cnt, poff);
#pragma unroll
        for (int e = 0; e < 32; ++e) { tab[e] = cnt[e]; tab[32 + e] = poff[e]; } tab[64] = poff[32]; }
    __syncthreads();
    const int ntile128 = tab[64] / 128;
    for (int it = F.bid; it < ntile128 * 8; it += F.G) {
        const int mt = it >> 3, nt = it & 7, pos0 = mt * 128;
        int e = 0;
        for (int q = 1; q < 32; ++q) if (pos0 >= tab[32 + q]) e = q;
        const int i0 = pos0 - tab[32 + e], cnt = tab[e];
        if (i0 >= cnt) continue;
        const int n0 = nt * 64;
        const bf16* W = UPT + (size_t)e * 1024 * 1024 + (size_t)((n0 >> 7) * 256 + (n0 & 127)) * DM;
        const bf16* const Bt[2] = { W, W + (size_t)128 * DM };
        const int* lst = LIST + (size_t)e * MTOT;
        ngemm_tile<2>(F, HB, DM, Bt, DM, DM, [&](int i) { return (i0 + i < cnt) ? (long)(lst[i0 + i] >> 1) : -1L; },
            [&](float (&acc)[2][4][4], int r0, int c0) {
#pragma unroll
                for (int i = 0; i < 4; ++i)
#pragma unroll
                    for (int j = 0; j < 4; ++j) HBUF[(size_t)(pos0 + r0 + i) * FF + n0 + c0 + j] = f2bf(siluf(acc[0][i][j]) * acc[1][i][j]);
            });
    }
}
__device__ __forceinline__ void ph_moe_dn_naive(Frame& F, int l) {
    const bf16* DNT = WSP(bf16, WS_DNT); const bf16* HBUF = WSP(bf16, WS_HBUF); const int* LIST = WSP(int, WS_LIST); const float* GATEV = WSP(float, WS_GATEV); bf16* FB = WSP(bf16, WS_F);
    const unsigned* CNT = WSP(unsigned, WS_CTL) + CW_CNT + l * 32 * CNT_STRIDE;
    int* tab = (int*)(F.lds + 64 * 1024);
    if (F.tid == 0) { int cnt[32], poff[33]; moe_offsets(CNT, cnt, poff);
#pragma unroll
        for (int e = 0; e < 32; ++e) { tab[e] = cnt[e]; tab[32 + e] = poff[e]; } tab[64] = poff[32]; }
    __syncthreads();
    const int ntile128 = tab[64] / 128;
    for (int it = F.bid; it < ntile128 * 16; it += F.G) {
        const int mt = it >> 4, nt = it & 15, pos0 = mt * 128;
        int e = 0;
        for (int q = 1; q < 32; ++q) if (pos0 >= tab[32 + q]) e = q;
        const int i0 = pos0 - tab[32 + e], cnt = tab[e];
        if (i0 >= cnt) continue;
        const int n0 = nt * 64;
        const bf16* const Bt[1] = { DNT + (size_t)e * 1024 * 512 + (size_t)n0 * FF };
        const int* lst = LIST + (size_t)e * MTOT;
        ngemm_tile<1>(F, HBUF, FF, Bt, FF, FF, [&](int i) { return (i0 + i < cnt) ? (long)(pos0 + i) : -1L; },
            [&](float (&acc)[1][4][4], int r0, int c0) {
#pragma unroll
                for (int i = 0; i < 4; ++i) { if (i0 + r0 + i < cnt) { const int ent = lst[i0 + r0 + i]; const int row = ent >> 1, k = ent & 1; const float gt = GATEV[ent];
#pragma unroll
                    for (int j = 0; j < 4; ++j) FB[((size_t)k * MTOT + row) * DM + n0 + c0 + j] = f2bf(gt * acc[0][i][j]); } }
            });
    }
}

namespace pg8 {
#define PG8_LAS __attribute__((address_space(3)))
typedef short bf16x8 __attribute__((ext_vector_type(8)));
constexpr int BM = 256, BK = 64, HALF = 128, HTB = HALF * BK * 2, STAGE_BYTES = 8 * HTB, NXCD = 8, WGM = 8;
__host__ __device__ __forceinline__ int lds_byte(int r, int c) { const int st = (r >> 4) * 2 + (c >> 5), rr = r & 15, cc = c & 31, ob = rr * 64 + cc * 2; return st * 1024 + (ob ^ (((ob >> 9) & 1) << 5)); }
__host__ __device__ __forceinline__ void stage_rc(int b, int& R, int& C) { const int st = b / 1024, sb = b % 1024, swz = sb ^ (((sb >> 9) & 1) << 5); R = (st >> 1) * 16 + swz / 64; C = (st & 1) * 32 + (swz % 64) / 2; }
__host__ __device__ __forceinline__ int perm32(int rho) { const int n = rho >> 4, i = rho & 15; return 8 * (i >> 2) + 4 * n + (i & 3); }
struct Unit { int pm, pn; size_t aoff, boff; int e, i0, cnt; };
struct StaticOrder {
    int nM, nN, nwg, G, c; size_t tstep;
    __device__ void init(int M, int N, int K, int G_, int c_) { nM = M / BM; nN = N / BM; nwg = nM * nN; G = G_; c = c_; tstep = (size_t)BM * K * 2; }
    __device__ bool next(int i, Unit& u) const {
        const long L = (long)i * G + c; if (L >= nwg) return false;
        int wgid = (int)L; { const int q = nwg / NXCD, r = nwg % NXCD, xcd = wgid % NXCD, off = wgid / NXCD; wgid = (xcd < r ? xcd * (q + 1) : r * (q + 1) + (xcd - r) * q) + off; }
        const int nig = WGM * nN, gid = wgid / nig, fm = gid * WGM, gsz = (nM - fm) < WGM ? (nM - fm) : WGM;
        u.pm = fm + ((wgid % nig) % gsz); u.pn = (wgid % nig) / gsz; u.aoff = (size_t)u.pm * tstep; u.boff = (size_t)u.pn * tstep; u.e = 0; u.i0 = 0; u.cnt = 0; return true;
    }
    __device__ unsigned gather_off(const Unit&, int) const { return 0u; }
};
template <bool GATH>
struct MoeOrder {
    const int* tab; const int* list; int npn, G, c, ntiles; size_t bstride_e; unsigned K2;
    __device__ bool next(int i, Unit& u) const {
        int mt, pn;
        if ((G & 7) == 0 && npn == 4) { const int x = c & 7, jj = c >> 3, per = G >> 3; const long uu = (long)i * per + jj; mt = (int)(uu >> 2) * 8 + x; pn = (int)(uu & 3); if (mt >= ntiles) return false; }
        else { const long L = (long)i * G + c; if (L >= (long)ntiles * npn) return false; mt = (int)(L / npn); pn = (int)(L % npn); }
        const int pos0 = mt * 256; int e = 0;
#pragma unroll
        for (int st = 16; st >= 1; st >>= 1) { const int pq = __builtin_amdgcn_readfirstlane(tab[32 + e + st]); if (pos0 >= pq) e += st; }
        u.pm = mt; u.pn = pn; u.e = e; u.i0 = pos0 - __builtin_amdgcn_readfirstlane(tab[32 + e]); u.cnt = __builtin_amdgcn_readfirstlane(tab[e]);
        u.aoff = GATH ? (size_t)0 : (size_t)pos0 * K2; u.boff = (size_t)e * bstride_e + (size_t)pn * 256 * K2; return true;
    }
    __device__ unsigned gather_off(const Unit& u, int r) const { const int idx = u.i0 + r; const int row = (idx < u.cnt) ? (list[(size_t)u.e * MTOT + idx] >> 1) : 0; return (unsigned)row * K2; }
};
__device__ __forceinline__ unsigned cvt_pk_bf16(float lo, float hi) { unsigned r; asm volatile("v_cvt_pk_bf16_f32 %0, %1, %2" : "=v"(r) : "v"(lo), "v"(hi)); return r; }

template <class Epi, class Sched, bool GATHER>
__device__ __forceinline__ void gemm_phase(PG8_LAS unsigned char* lds, const char* Abase, const char* Bbase, int K, const Sched& S, const Epi& E) {
    const int tid = threadIdx.x, wid = __builtin_amdgcn_readfirstlane(tid >> 6), lane = tid & 63, wr = wid >> 2, wc = wid & 3, fr = lane & 15, fq = lane >> 4;
    const int nt = K / BK;
    unsigned voffA[2], voffB[2]; int RA[2];
#pragma unroll
    for (int i = 0; i < 2; ++i) { int R, C; stage_rc(tid * 16 + i * 8192, R, C); const int Rb = Epi::PERM ? ((R & ~31) + perm32(R & 31)) : R;
        RA[i] = R; voffA[i] = GATHER ? (unsigned)(C * 2) : (unsigned)(R * K + C) * 2u; voffB[i] = (unsigned)(Rb * K + C) * 2u; }
    const size_t kstep = (size_t)(BK * 2);
    const size_t hstep = (size_t)HALF * K * 2;
    const size_t hstepA = GATHER ? (size_t)0 : hstep;
    const unsigned ldsw = (unsigned)wid * 1024u;
    const int aoff = lds_byte(wr * 64 + fr, fq * 8), boff = lds_byte(wc * 32 + fr, fq * 8);
    unsigned gC[2][2], gN[2][2];
#define PG8_SA(b, h) (((b) * 2 + (h)) * HTB)
#define PG8_SB(b, h) ((4 + (b) * 2 + (h)) * HTB)
#define PG8_STAGE(bufoff, gbase, voff) do { _Pragma("unroll") for (int _i = 0; _i < 2; ++_i) \
        __builtin_amdgcn_global_load_lds((const unsigned*)((const char*)(gbase) + (voff)[_i]), (PG8_LAS unsigned*)(lds + (bufoff) + ldsw + _i * 8192), 16, 0, 0); } while (0)
#define PG8_STAGE_A(bufoff, gbase, h, NX) do { if constexpr (GATHER) { _Pragma("unroll") for (int _i = 0; _i < 2; ++_i) \
        __builtin_amdgcn_global_load_lds((const unsigned*)((const char*)(gbase) + ((NX) ? gN[h][_i] : gC[h][_i])), (PG8_LAS unsigned*)(lds + (bufoff) + ldsw + _i * 8192), 16, 0, 0); } \
        else { PG8_STAGE(bufoff, (const char*)(gbase) + (h) * hstepA, voffA); } } while (0)
#define PG8_LDA(dst, b, h) do { _Pragma("unroll") for (int m = 0; m < 4; ++m) _Pragma("unroll") for (int k = 0; k < 2; ++k) dst[m][k] = *(const PG8_LAS bf16x8*)(lds + PG8_SA(b, h) + aoff + m * 2048 + k * 1024); } while (0)
#define PG8_LDB(dst, b, h) do { _Pragma("unroll") for (int n = 0; n < 2; ++n) _Pragma("unroll") for (int k = 0; k < 2; ++k) dst[n][k] = *(const PG8_LAS bf16x8*)(lds + PG8_SB(b, h) + boff + n * 2048 + k * 1024); } while (0)
#define PG8_MMA(ai, bj, At, Bt) do { __builtin_amdgcn_s_setprio(1); _Pragma("unroll") for (int m = 0; m < 4; ++m) _Pragma("unroll") for (int n = 0; n < 2; ++n) _Pragma("unroll") for (int k = 0; k < 2; ++k) \
        acc[ai][bj][m][n] = __builtin_amdgcn_mfma_f32_16x16x32_bf16(Bt[n][k], At[m][k], acc[ai][bj][m][n], 0, 0, 0); __builtin_amdgcn_s_setprio(0); } while (0)
#define PG8_WAIT_V(n) asm volatile("s_waitcnt vmcnt(" #n ")" ::: "memory")
#define PG8_WAIT_L(n) asm volatile("s_waitcnt lgkmcnt(" #n ")" ::: "memory")
#define PG8_BAR __builtin_amdgcn_s_barrier()
#define PG8_SCHED __builtin_amdgcn_sched_barrier(0)
    Unit cur, nxt; int ui = 0;
    if (!S.next(0, cur)) return;
    f32x4 acc[2][2][4][2];
#pragma unroll
    for (int a = 0; a < 2; ++a)
#pragma unroll
        for (int b = 0; b < 2; ++b)
#pragma unroll
            for (int m = 0; m < 4; ++m)
#pragma unroll
                for (int n = 0; n < 2; ++n) acc[a][b][m][n] = (f32x4){0.f, 0.f, 0.f, 0.f};
    bf16x8 At[4][2], B0[2][2], B1[2][2];
    const char* cA = Abase + cur.aoff; const char* cB = Bbase + cur.boff;
    if constexpr (GATHER) {
#pragma unroll
        for (int h = 0; h < 2; ++h)
#pragma unroll
            for (int i = 0; i < 2; ++i) { gC[h][i] = S.gather_off(cur, h * HALF + RA[i]) + voffA[i]; gN[h][i] = gC[h][i]; }
    }
    PG8_STAGE(PG8_SB(0, 0), cB, voffB); PG8_STAGE(PG8_SB(0, 1), cB + hstep, voffB); PG8_STAGE_A(PG8_SA(0, 0), cA, 0, false); PG8_STAGE_A(PG8_SA(0, 1), cA, 1, false);
    if (wr == 1) PG8_BAR;
    PG8_WAIT_V(2); PG8_BAR;
    PG8_STAGE(PG8_SB(1, 0), cB + kstep, voffB); PG8_STAGE_A(PG8_SA(1, 0), cA + kstep, 0, false); PG8_STAGE(PG8_SB(1, 1), cB + hstep + kstep, voffB);
    PG8_WAIT_V(6); PG8_BAR;
    for (;;) {
        const bool has_next = S.next(ui + 1, nxt);
        const char* nA = has_next ? Abase + nxt.aoff : cA; const char* nB = has_next ? Bbase + nxt.boff : cB;
        if constexpr (GATHER) { if (has_next) {
#pragma unroll
            for (int h = 0; h < 2; ++h)
#pragma unroll
                for (int i = 0; i < 2; ++i) gN[h][i] = S.gather_off(nxt, h * HALF + RA[i]) + voffA[i]; } }
        for (int t = 0; t < nt; t += 2) {
            const bool last = (t == nt - 2);
            const char* a1 = cA + (size_t)(t + 1) * kstep;
            const char* a2 = last ? nA : cA + (size_t)(t + 2) * kstep; const char* b2 = last ? nB : cB + (size_t)(t + 2) * kstep;
            const char* a3 = a2 + kstep; const char* b3 = b2 + kstep;
            PG8_LDB(B0, 0, 0); PG8_LDB(B1, 0, 1); PG8_SCHED; PG8_LDA(At, 0, 0); PG8_STAGE_A(PG8_SA(1, 1), a1, 1, false);
            PG8_WAIT_V(8); PG8_WAIT_L(0); PG8_BAR; PG8_MMA(0, 0, At, B0); PG8_MMA(0, 1, At, B1); PG8_BAR; PG8_SCHED;
            PG8_LDA(At, 0, 1); PG8_STAGE(PG8_SB(0, 0), b2, voffB); PG8_STAGE(PG8_SB(0, 1), b2 + hstep, voffB); PG8_STAGE_A(PG8_SA(0, 0), a2, 0, last);
            PG8_WAIT_V(8); PG8_WAIT_L(0); PG8_BAR; PG8_MMA(1, 0, At, B0); PG8_MMA(1, 1, At, B1); PG8_BAR; PG8_SCHED;
            PG8_LDB(B0, 1, 0); PG8_LDB(B1, 1, 1); PG8_SCHED; PG8_LDA(At, 1, 0); PG8_STAGE_A(PG8_SA(0, 1), a2, 1, last);
            PG8_WAIT_V(8); PG8_WAIT_L(0); PG8_BAR; PG8_MMA(0, 0, At, B0); PG8_MMA(0, 1, At, B1); PG8_BAR; PG8_SCHED;
            PG8_LDA(At, 1, 1); PG8_STAGE(PG8_SB(1, 0), b3, voffB); PG8_STAGE(PG8_SB(1, 1), b3 + hstep, voffB); PG8_STAGE_A(PG8_SA(1, 0), a3, 0, last);
            PG8_WAIT_V(8); PG8_WAIT_L(0); PG8_BAR; PG8_MMA(1, 0, At, B0); PG8_MMA(1, 1, At, B1); PG8_BAR; PG8_SCHED;
        }
        if (wr == 0) PG8_BAR;
        E(acc, cur, wr, wc, fr, fq);
        if (!has_next) break;
#pragma unroll
        for (int a = 0; a < 2; ++a)
#pragma unroll
            for (int b = 0; b < 2; ++b)
#pragma unroll
                for (int m = 0; m < 4; ++m)
#pragma unroll
                    for (int n = 0; n < 2; ++n) acc[a][b][m][n] = (f32x4){0.f, 0.f, 0.f, 0.f};
        cur = nxt; cA = nA; cB = nB; ++ui;
        if constexpr (GATHER) {
#pragma unroll
            for (int h = 0; h < 2; ++h)
#pragma unroll
                for (int i = 0; i < 2; ++i) gC[h][i] = gN[h][i]; }
        if (wr == 1) PG8_BAR;
    }
    PG8_WAIT_V(0);
    PG8_BAR;
#undef PG8_SA
#undef PG8_SB
#undef PG8_STAGE
#undef PG8_STAGE_A
#undef PG8_LDA
#undef PG8_LDB
#undef PG8_MMA
#undef PG8_WAIT_V
#undef PG8_WAIT_L
#undef PG8_BAR
#undef PG8_SCHED
}
struct EpiWin { static constexpr bool PERM = true; bf16* U; float* GT; const float* bias; const float* rc; const float* rs;
    __device__ __forceinline__ void operator()(const f32x4 (&acc)[2][2][4][2], const Unit& u, int wr, int wc, int fr, int fq) const {
        const int row0 = u.pm * BM + wr * 64 + fr;
        if (u.pn < 13) {
            const int col0 = u.pn * BM + wc * 32 + 8 * fq;
            f32x4 bv[2][2];
#pragma unroll
            for (int bj = 0; bj < 2; ++bj)
#pragma unroll
                for (int n = 0; n < 2; ++n) bv[bj][n] = *(const f32x4*)(bias + col0 + bj * HALF + 4 * n);
            const bool rope_ = (u.pn >= 7 && u.pn <= 10);
#pragma unroll
            for (int ai = 0; ai < 2; ++ai) {
                f32x4 c4v[4], s4v[4];
                if (rope_) {
#pragma unroll
                    for (int m = 0; m < 4; ++m) { const int row = row0 + ai * HALF + m * 16; const int ti = ((row < NLAT) ? (row & 4095) : 0) * 32 + (wc & 1) * 16 + 4 * fq; c4v[m] = *(const f32x4*)(rc + ti); s4v[m] = *(const f32x4*)(rs + ti); }
                }
#pragma unroll
                for (int m = 0; m < 4; ++m) { bf16* rowp = U + (size_t)(row0 + ai * HALF + m * 16) * UW + col0;
#pragma unroll
                    for (int bj = 0; bj < 2; ++bj) { f32x4 v0 = acc[ai][bj][m][0] + bv[bj][0], v1 = acc[ai][bj][m][1] + bv[bj][1];
                        if (rope_) {
                            const int row = row0 + ai * HALF + m * 16; const float sc = (u.pn <= 8) ? QSCALE : 1.f;
                            if (row < NLAT) { const f32x4 c4 = c4v[m], s4 = s4v[m];
                                const f32x4 a0 = v0, a1 = v1;
                                v0[0] = (a0[0] * c4[0] - a0[1] * s4[0]) * sc; v0[1] = (a0[1] * c4[0] + a0[0] * s4[0]) * sc; v0[2] = (a0[2] * c4[1] - a0[3] * s4[1]) * sc; v0[3] = (a0[3] * c4[1] + a0[2] * s4[1]) * sc;
                                v1[0] = (a1[0] * c4[2] - a1[1] * s4[2]) * sc; v1[1] = (a1[1] * c4[2] + a1[0] * s4[2]) * sc; v1[2] = (a1[2] * c4[3] - a1[3] * s4[3]) * sc; v1[3] = (a1[3] * c4[3] + a1[2] * s4[3]) * sc; }
                            else { v0 = v0 * sc; v1 = v1 * sc; } }
                        u32x4 w; w.x = cvt_pk_bf16(v0[0], v0[1]); w.y = cvt_pk_bf16(v0[2], v0[3]); w.z = cvt_pk_bf16(v1[0], v1[1]); w.w = cvt_pk_bf16(v1[2], v1[3]);
                        *(u32x4*)(rowp + bj * HALF) = w; } } }
        } else if (wc == 0 && fq < 2) {
            const f32x4 b0 = *(const f32x4*)(bias + UW + 8 * fq), b1 = *(const f32x4*)(bias + UW + 8 * fq + 4);
#pragma unroll
            for (int ai = 0; ai < 2; ++ai)
#pragma unroll
                for (int m = 0; m < 4; ++m) { float* g = GT + (size_t)(row0 + ai * HALF + m * 16) * 16 + 8 * fq;
                    *(f32x4*)g = acc[ai][0][m][0] + b0; *(f32x4*)(g + 4) = acc[ai][0][m][1] + b1; }
        }
    }
};
struct EpiWout { static constexpr bool PERM = false; float* out; unsigned char* ws; const float* mods_l;
    __device__ __forceinline__ void operator()(const f32x4 (&acc)[2][2][4][2], const Unit& u, int wr, int wc, int fr, int fq) const {
        const int rt = u.pm * BM; const int bsel = rt < NLAT ? (rt >> 12) : 8;
        const float* g1 = mods_l + (size_t)bsel * 6144 + 2 * DM;
        const int r0 = rt + wr * 64 + fr, col0 = u.pn * BM + wc * 32 + 4 * fq;
        f32x4 gv[2][2];
#pragma unroll
        for (int bj = 0; bj < 2; ++bj)
#pragma unroll
            for (int n = 0; n < 2; ++n) gv[bj][n] = *(const f32x4*)(g1 + col0 + bj * HALF + n * 16);
#pragma unroll
        for (int ai = 0; ai < 2; ++ai) {
            u32x2 xv[4][2][2];
#pragma unroll
            for (int m = 0; m < 4; ++m) { const bf16* rowp = xrow_ptr(out, ws, r0 + ai * HALF + m * 16) + col0;
#pragma unroll
                for (int bj = 0; bj < 2; ++bj)
#pragma unroll
                    for (int n = 0; n < 2; ++n) xv[m][bj][n] = *(const u32x2*)(rowp + bj * HALF + n * 16); }
#pragma unroll
            for (int m = 0; m < 4; ++m) { bf16* rowp = xrow_ptr(out, ws, r0 + ai * HALF + m * 16) + col0;
#pragma unroll
                for (int bj = 0; bj < 2; ++bj)
#pragma unroll
                    for (int n = 0; n < 2; ++n) { const u32x2 x1 = xv[m][bj][n]; const f32x4 y = gv[bj][n] * acc[ai][bj][m][n];
                        u32x2 xo; xo.x = cvt_pk_bf16(__uint_as_float(x1.x << 16) + y[0], __uint_as_float(x1.x & 0xffff0000u) + y[1]); xo.y = cvt_pk_bf16(__uint_as_float(x1.y << 16) + y[2], __uint_as_float(x1.y & 0xffff0000u) + y[3]);
                        *(u32x2*)(rowp + bj * HALF + n * 16) = xo; } } }
    }
};
struct EpiMoeUp { static constexpr bool PERM = true; bf16* HBUF;
    __device__ __forceinline__ void operator()(const f32x4 (&acc)[2][2][4][2], const Unit& u, int wr, int wc, int fr, int fq) const {
        const int row0 = u.pm * BM + wr * 64 + fr, col0 = u.pn * HALF + wc * 32 + 8 * fq;
#pragma unroll
        for (int ai = 0; ai < 2; ++ai)
#pragma unroll
            for (int m = 0; m < 4; ++m) { float h[8];
#pragma unroll
                for (int n = 0; n < 2; ++n)
#pragma unroll
                    for (int j = 0; j < 4; ++j) { const float a = acc[ai][0][m][n][j], b = acc[ai][1][m][n][j]; h[n * 4 + j] = a * __builtin_amdgcn_rcpf(1.f + __expf(-a)) * b; }
                u32x4 w; w.x = cvt_pk_bf16(h[0], h[1]); w.y = cvt_pk_bf16(h[2], h[3]); w.z = cvt_pk_bf16(h[4], h[5]); w.w = cvt_pk_bf16(h[6], h[7]);
                *(u32x4*)(HBUF + (size_t)(row0 + ai * HALF + m * 16) * FF + col0) = w; }
    }
};
struct EpiMoeDn { static constexpr bool PERM = true; bf16* FB; const int* list; const float* gatev;
    __device__ __forceinline__ void operator()(const f32x4 (&acc)[2][2][4][2], const Unit& u, int wr, int wc, int fr, int fq) const {
        const int col0 = u.pn * BM + wc * 32 + 8 * fq; const int* lst = list + (size_t)u.e * MTOT;
        int ent[2][4]; float g[2][4];
#pragma unroll
        for (int ai = 0; ai < 2; ++ai)
#pragma unroll
            for (int m = 0; m < 4; ++m) { const int idx = u.i0 + ai * HALF + wr * 64 + m * 16 + fr; ent[ai][m] = (idx < u.cnt) ? lst[idx] : -1; }
#pragma unroll
        for (int ai = 0; ai < 2; ++ai)
#pragma unroll
            for (int m = 0; m < 4; ++m) g[ai][m] = (ent[ai][m] >= 0) ? gatev[ent[ai][m]] : 0.f;
#pragma unroll
        for (int ai = 0; ai < 2; ++ai)
#pragma unroll
            for (int m = 0; m < 4; ++m) {
                if (ent[ai][m] >= 0) { const int en = ent[ai][m]; const float gg = g[ai][m]; bf16* rowp = FB + ((size_t)(en & 1) * MTOT + (en >> 1)) * DM + col0;
#pragma unroll
                    for (int bj = 0; bj < 2; ++bj) { const f32x4 v0 = acc[ai][bj][m][0] * gg, v1 = acc[ai][bj][m][1] * gg;
                        u32x4 w; w.x = cvt_pk_bf16(v0[0], v0[1]); w.y = cvt_pk_bf16(v0[2], v0[3]); w.z = cvt_pk_bf16(v1[0], v1[1]); w.w = cvt_pk_bf16(v1[2], v1[3]);
                        *(u32x4*)(rowp + bj * HALF) = w; } } }
    }
};
}

__device__ __forceinline__ void ph_win_fast(Frame& F, int l) {
    pg8::StaticOrder S; S.init(MTOT, UW, DM, F.G, F.bid);
    pg8::EpiWin E{WSP(bf16, WS_U), WSP(float, WS_GATES), WSP(float, WS_BINR) + l * NPADW, WSP(float, WS_ROPE), WSP(float, WS_ROPE) + 4096 * 32};
    pg8::gemm_phase<pg8::EpiWin, pg8::StaticOrder, false>((PG8_LAS unsigned char*)F.lds, (const char*)WSP(bf16, WS_HB), (const char*)(WSP(bf16, WS_WIN) + (size_t)l * NPADW * DM), DM, S, E);
}
__device__ __forceinline__ void ph_gates(Frame& F, int l) {
    typedef short bf16x8g __attribute__((ext_vector_type(8))); typedef float f32x16g __attribute__((ext_vector_type(16)));
    const bf16* HB = WSP(bf16, WS_HB); const bf16* W = WSP(bf16, WS_WIN) + (size_t)l * NPADW * DM + (size_t)UW * DM; const float* bias = WSP(float, WS_BINR) + l * NPADW + UW; float* GT = WSP(float, WS_GATES);
    const int gw = F.bid * NWAVES + F.wave, NGW = F.G * NWAVES, r32 = F.lane & 31, hi = F.lane >> 5;
    for (int it = F.wave * F.G + F.bid; it < MTOT / 32; it += NGW) {
        const bf16* ap = HB + (size_t)(it * 32 + r32) * DM + 8 * hi; const bf16* bp = W + (size_t)r32 * DM + 8 * hi;
        f32x16g acc = f32x16g{};
#pragma unroll 1
        for (int kb = 0; kb < 64; kb += 16) { bf16x8g av[16], bv[16];
#pragma unroll
            for (int ks = 0; ks < 16; ++ks) { av[ks] = *(const bf16x8g*)(ap + 16 * (kb + ks)); bv[ks] = *(const bf16x8g*)(bp + 16 * (kb + ks)); }
            __builtin_amdgcn_sched_barrier(0);
#pragma unroll
            for (int ks = 0; ks < 16; ++ks) acc = __builtin_amdgcn_mfma_f32_32x32x16_bf16(av[ks], bv[ks], acc, 0, 0, 0);
            __builtin_amdgcn_sched_barrier(0); }
        if (r32 < 16) { const float bv = bias[r32];
#pragma unroll
            for (int r = 0; r < 16; ++r) GT[(size_t)(it * 32 + (r & 3) + 8 * (r >> 2) + 4 * hi) * 16 + r32] = acc[r] + bv; }
    }
}
__device__ __forceinline__ void ph_wout_fast(Frame& F, int l) {
    pg8::StaticOrder S; S.init((l == 1) ? NLAT : MTOT, DM, DM, F.G, F.bid);
    pg8::EpiWout E{F.p->out, F.ws, WSP(float, WS_MODS) + (size_t)l * 9 * 6144};
    pg8::gemm_phase<pg8::EpiWout, pg8::StaticOrder, false>((PG8_LAS unsigned char*)F.lds, (const char*)WSP(bf16, WS_HB), (const char*)(WSP(bf16, WS_WOUT) + (size_t)l * DM * DM), DM, S, E);
}
__device__ __forceinline__ void moe_tab(Frame& F, int l, int* tab) {
    const unsigned* CNT = WSP(unsigned, WS_CTL) + CW_CNT + l * 32 * CNT_STRIDE;
    if (F.tid < 32) tab[F.tid] = (int)__hip_atomic_load(CNT + F.tid * CNT_STRIDE, __ATOMIC_RELAXED, __HIP_MEMORY_SCOPE_AGENT);
    __syncthreads();
    if (F.tid == 0) { int acc = 0;
#pragma unroll 1
        for (int e = 0; e < 32; ++e) { const int c = tab[e]; tab[32 + e] = acc; acc += ((c + 255) >> 8) << 8; }
        tab[64] = acc; }
    __syncthreads();
}
__device__ __forceinline__ void ph_moe_up_fast(Frame& F, int l) {
    int* tab = (int*)(F.lds + 136 * 1024); moe_tab(F, l, tab);
    pg8::MoeOrder<true> S{tab, WSP(int, WS_LIST), 4, F.G, F.bid, __builtin_amdgcn_readfirstlane(tab[64]) / 256, (size_t)1024 * 1024 * 2, (unsigned)(DM * 2)};
    pg8::EpiMoeUp E{WSP(bf16, WS_HBUF)};
    pg8::gemm_phase<pg8::EpiMoeUp, pg8::MoeOrder<true>, true>((PG8_LAS unsigned char*)F.lds, (const char*)WSP(bf16, WS_HB), (const char*)WSP(bf16, WS_UPT), DM, S, E);
}
__device__ __forceinline__ void ph_moe_dn_fast(Frame& F, int l) {
    int* tab = (int*)(F.lds + 136 * 1024); moe_tab(F, l, tab);
    pg8::MoeOrder<false> S{tab, WSP(int, WS_LIST), 4, F.G, F.bid, __builtin_amdgcn_readfirstlane(tab[64]) / 256, (size_t)1024 * 512 * 2, (unsigned)(FF * 2)};
    pg8::EpiMoeDn E{WSP(bf16, WS_F), WSP(int, WS_LIST), WSP(float, WS_GATEV)};
    pg8::gemm_phase<pg8::EpiMoeDn, pg8::MoeOrder<false>, false>((PG8_LAS unsigned char*)F.lds, (const char*)WSP(bf16, WS_HBUF), (const char*)WSP(bf16, WS_DNT), FF, S, E);
}


#ifndef FAST_GEMM
#define FAST_GEMM 1
#endif
#ifndef FAST_MOE
#define FAST_MOE 1
#endif
constexpr int NPH = 20;
__global__ void __launch_bounds__(NTHREADS, 2) mega(Params prm) {
    extern __shared__ __attribute__((aligned(16))) unsigned char lds[];
    const int g_wave0 = __builtin_amdgcn_readfirstlane(threadIdx.x >> 6);
#define mkframe(L) mkframe_(L, g_wave0)
    Frame F = mkframe(lds);
    volatile LAS unsigned* st = (volatile LAS unsigned*)(LAS unsigned char*)(lds + LDS_CTL_OFF);
    if (F.tid < 64) st[F.tid] = 0u;
    __syncthreads();
    const int lo = prm.ph_lo, hi = prm.ph_hi;
    const bool multi = (hi - lo) > 1;
    XcdBarrier bar; bar.bar = WSP(unsigned, WS_CTL) + CW_BAR; bar.x = 0; bar.st = st;
    if (multi) bar = xcd_barrier_post(WSP(unsigned, WS_CTL) + CW_BAR, st);
#ifndef PHMASK
#define PHMASK 0xFFFFF
#endif
#define IN(k) (((PHMASK >> (((k) == 0) ? 0 : ((k) == 19) ? 10 : (((k) - 1) % 9 + 1))) & 1) && lo <= (k) && (k) < hi)
#define SEAM(k) do { if (IN(k) && IN((k) + 1)) xcd_barrier(bar); } while (0)
    if (IN(0)) { F = mkframe(lds); for (int rep = 0; rep < DUP(8); ++rep) { ph_prologue(F); __syncthreads(); } ph_prologue_b(F); } SEAM(0);
#define LAYER_BODY(l) { constexpr int pb = 1 + 9 * (l);\
        if (IN(pb + 0)) { F = mkframe(lds); ph_norm1<false>(F, l); if (l == 0 && DUP(9) == 2) ph_norm1<false>(F, l); if (l == 1 && !DYN_MIX) conv_moe_weights(F, 1); } SEAM(pb + 0);\
        if (IN(pb + 1)) { F = mkframe(lds); ph_win_fast(F, l); __syncthreads(); ph_gates(F, l); if (DUP(3) == 2) { __syncthreads(); F = mkframe(lds); ph_win_fast(F, l); } } SEAM(pb + 1);\
        if (IN(pb + 2)) { F = mkframe(lds); ph_postu(F, l); __syncthreads(); ph_taps(F, l); if (DUP(11) == 2) { __syncthreads(); ph_postu(F, l); } if (FAST_MLSTM) { for (int rep = 0; rep < DUP(4); ++rep) { __syncthreads(); ph_ml_s1(F, l); } } } SEAM(pb + 2);\
        if (IN(pb + 3)) { F = mkframe(lds); if (DYN_MIX) ph_mixers_dyn(F, l, lds); else ph_mixers_naive(F, l); } SEAM(pb + 3);\
        if (IN(pb + 4)) { F = mkframe(lds); for (int rep = 0; rep < DUP(5); ++rep) { ph_assemble(F, l); __syncthreads(); } } SEAM(pb + 4);\
        if (IN(pb + 5)) { F = mkframe(lds); if (FAST_GEMM) ph_wout_fast(F, l); else ph_wout_naive(F, l); } SEAM(pb + 5);\
        if (IN(pb + 6)) { F = mkframe(lds); ph_norm2_router<false>(F, l); if (DUP(10) == 2) { __syncthreads(); ph_norm2_router<true>(F, l); } } SEAM(pb + 6);\
        if (IN(pb + 7)) { F = mkframe(lds); ph_moe_up_fast(F, l); if (DUP(6) == 2) { __syncthreads(); F = mkframe(lds); ph_moe_up_fast(F, l); } } SEAM(pb + 7);\
        if (IN(pb + 8)) { F = mkframe(lds); ph_moe_dn_fast(F, l); if (DUP(7) == 2) { __syncthreads(); F = mkframe(lds); ph_moe_dn_fast(F, l); } } SEAM(pb + 8);\
    }
    LAYER_BODY(0)
    LAYER_BODY(1)
#undef LAYER_BODY
    if (IN(19)) { F = mkframe(lds); ph_norm1<true>(F, 2); }
#undef IN
#undef SEAM
}

#ifndef MK_ONE_LAUNCH
#define MK_ONE_LAUNCH 1
#endif
extern "C" void kernel_launch(void* const* d_in, const int* in_sizes, int n_in, void* d_out, int out_size, void* d_ws, size_t ws_size, hipStream_t stream) {
    static int grid = 0;
    if (grid == 0) {
        if (n_in != 34 || out_size != NLAT * DM || ws_size < WS_END) { fprintf(stderr, "kernel_launch: unexpected problem (n_in %d out %d ws %zu)\n", n_in, out_size, ws_size); grid = -1; return; }
        int dev = 0, cus = 0;
        if (hipGetDevice(&dev) != hipSuccess || hipDeviceGetAttribute(&cus, hipDeviceAttributeMultiprocessorCount, dev) != hipSuccess) { grid = -1; return; }
        if (hipFuncSetAttribute((const void*)mega, hipFuncAttributeMaxDynamicSharedMemorySize, LDS_BYTES) != hipSuccess) { fprintf(stderr, "kernel_launch: hipFuncSetAttribute failed\n"); grid = -1; return; }
        int per_cu = 0;
        if (hipOccupancyMaxActiveBlocksPerMultiprocessor(&per_cu, (const void*)mega, NTHREADS, LDS_BYTES) != hipSuccess || per_cu < 1) { fprintf(stderr, "kernel_launch: occupancy query says %d\n", per_cu); }
        (void)hipGetLastError();
        grid = cus;
    }
    if (grid < 0) return;
    (void)hipMemsetAsync((char*)d_ws + WS_CTL, 0, CTL_BYTES, stream);
    Params p{};
    for (int i = 0; i < 34; ++i) p.in[i] = (const float*)d_in[i];
    p.out = (float*)d_out; p.ws = (unsigned char*)d_ws;
#if MK_ONE_LAUNCH
    p.ph_lo = 0; p.ph_hi = NPH;
    hipLaunchKernelGGL(mega, dim3(grid), dim3(NTHREADS), LDS_BYTES, stream, p);
#else
    for (int k = 0; k < NPH; ++k) { p.ph_lo = k; p.ph_hi = k + 1; hipLaunchKernelGGL(mega, dim3(grid), dim3(NTHREADS), LDS_BYTES, stream, p); }
#endif
}
```
